# Optimizing an MI355X kernel written in HIP

```python
import jax, jax.numpy as jnp
from jax import lax
import numpy as np

D_MODEL = 1024
BATCH = 16
SEQ = 4096
DEPTH = 4

N_MEM = 256
N_EVEN = (DEPTH + 1) // 2
N_ODD = DEPTH // 2
A_WIDTH = D_MODEL // 2
A_CONV = 3
B_WIDTH = D_MODEL
B_HEADS = 8
B_HEAD_DIM = B_WIDTH // B_HEADS
B_CONV = 4
LRU_C = 8.0
EV_IN = 3 * A_WIDTH + 2 * B_WIDTH
M_HEADS = 4
M_QK_DIM = D_MODEL // 8
M_V_DIM = D_MODEL // 4
M_QK = M_HEADS * M_QK_DIM
M_V = M_HEADS * M_V_DIM
OD_IN = 2 * M_QK + 2 * M_V + 2 * M_HEADS
M_CHUNK = 128
X_HEADS = 4
X_HEAD_DIM = D_MODEL // X_HEADS
N_EXPERTS = 32
TOP_K = 4
D_FF = D_MODEL
SWIGLU_LIMIT = 7.0
SWIGLU_ALPHA = 1.702
DN_ALPHA = (2 * DEPTH) ** 0.25
DN_BETA = (8 * DEPTH) ** -0.25
LN_EPS = 1e-5
RMS_EPS = 1e-6

kernel_name = 'hybrid_conv_rglru_mlstm_moe_deepnorm'


def layer_norm(x, g, b):
    xf = x.astype(jnp.float32)
    mu = jnp.mean(xf, axis=-1, keepdims=True)
    var = jnp.mean(jnp.square(xf - mu), axis=-1, keepdims=True)
    return ((xf - mu) * lax.rsqrt(var + LN_EPS) * g + b).astype(x.dtype)


def causal_conv(x, w):
    k = w.shape[0]
    return lax.conv_general_dilated(
        x, w[:, None, :], window_strides=(1,), padding=[(k - 1, 0)],
        dimension_numbers=('NWC', 'WIO', 'NWC'), feature_group_count=x.shape[-1])


def rg_lru(u, w_r, b_r, w_i, b_i, lam):
    bsz, s, _ = u.shape
    uh = u.reshape(bsz, s, B_HEADS, B_HEAD_DIM)
    r = jax.nn.sigmoid(jnp.einsum('bshd,hde->bshe', uh, w_r).reshape(bsz, s, B_WIDTH) + b_r)
    ig = jax.nn.sigmoid(jnp.einsum('bshd,hde->bshe', uh, w_i).reshape(bsz, s, B_WIDTH) + b_i)
    log_a = -LRU_C * r.astype(jnp.float32) * jax.nn.softplus(-lam.astype(jnp.float32))
    a = jnp.exp(log_a)
    inp = jnp.sqrt(-jnp.expm1(2.0 * log_a)) * (ig * u).astype(jnp.float32)

    def combine(left, right):
        a1, b1 = left
        a2, b2 = right
        return a1 * a2, a2 * b1 + b2

    _, h = lax.associative_scan(combine, (a, inp), axis=1)
    return h.astype(u.dtype)


def even_mixer(x, w_in, conv_a, conv_b, conv_b_bias, w_r, b_r, w_i, b_i, lam, w_out):
    z = x @ w_in
    a_b, a_c, a_x, b_u, b_g = jnp.split(
        z, [A_WIDTH, 2 * A_WIDTH, 3 * A_WIDTH, 3 * A_WIDTH + B_WIDTH], axis=-1)
    y_a = a_b * causal_conv(a_c * a_x, conv_a)
    u = causal_conv(b_u, conv_b) + conv_b_bias
    y_b = jax.nn.gelu(b_g) * rg_lru(u, w_r, b_r, w_i, b_i, lam)
    return jnp.concatenate([y_a, y_b], axis=-1) @ w_out


def to_chunks(t):
    bsz, s = t.shape[:2]
    t = t.reshape(bsz, s // M_CHUNK, M_CHUNK, *t.shape[2:])
    return jnp.moveaxis(jnp.moveaxis(t, 1, 0), 3, 2)


def mlstm_chunkwise(q, k, v, i_pre, log_f):
    bsz, s, nh, dk = q.shape
    dv = v.shape[-1]
    causal = jnp.tril(jnp.ones((M_CHUNK, M_CHUNK), dtype=bool))

    def step(carry, xs):
        c_st, n_st, m_st = carry
        qc, kc, vc, ic, fc = xs
        b = jnp.cumsum(fc, axis=-1)
        d = b[..., :, None] - b[..., None, :] + ic[..., None, :]
        d = jnp.where(causal, d, -jnp.inf)
        inter = b + m_st[..., None]
        m_t = jnp.maximum(inter, jnp.max(d, axis=-1))
        p = jnp.exp(d - m_t[..., None])
        w_inter = jnp.exp(inter - m_t)
        qk = jnp.einsum('bhtd,bhsd->bhts', qc, kc) * p
        num = jnp.einsum('bhts,bhsv->bhtv', qk, vc) + w_inter[..., None] * jnp.einsum('bhtd,bhdv->bhtv', qc, c_st)
        den = jnp.sum(qk, axis=-1) + w_inter * jnp.einsum('bhtd,bhd->bht', qc, n_st)
        h = num / jnp.maximum(jnp.abs(den), jnp.exp(-m_t))[..., None]
        b_end = b[..., -1]
        g = b_end[..., None] - b + ic
        m_new = jnp.maximum(b_end + m_st, jnp.max(g, axis=-1))
        wg = jnp.exp(g - m_new[..., None])
        decay = jnp.exp(b_end + m_st - m_new)
        c_new = decay[..., None, None] * c_st + jnp.einsum('bhs,bhsd,bhsv->bhdv', wg, kc, vc)
        n_new = decay[..., None] * n_st + jnp.einsum('bhs,bhsd->bhd', wg, kc)
        return (c_new, n_new, m_new), h

    init = (jnp.zeros((bsz, nh, dk, dv), jnp.float32),
            jnp.zeros((bsz, nh, dk), jnp.float32),
            jnp.zeros((bsz, nh), jnp.float32))
    xs = (to_chunks(q), to_chunks(k), to_chunks(v), to_chunks(i_pre), to_chunks(log_f))
    _, h = lax.scan(step, init, xs)
    h = jnp.moveaxis(jnp.moveaxis(h, 0, 1), 2, 3)
    return h.reshape(bsz, s, nh, dv)


def odd_mixer(x, w_in, b_gates, norm_g, w_out):
    bsz, s, _ = x.shape
    z = x @ w_in
    q, k, v, o, gates = jnp.split(z, [M_QK, 2 * M_QK, 2 * M_QK + M_V, 2 * M_QK + 2 * M_V], axis=-1)
    q = q.reshape(bsz, s, M_HEADS, M_QK_DIM).astype(jnp.float32) * (M_QK_DIM ** -0.5)
    k = k.reshape(bsz, s, M_HEADS, M_QK_DIM).astype(jnp.float32)
    v = v.reshape(bsz, s, M_HEADS, M_V_DIM).astype(jnp.float32)
    gates = gates.astype(jnp.float32) + b_gates.astype(jnp.float32)
    i_pre, f_pre = gates[..., :M_HEADS], gates[..., M_HEADS:]
    h = mlstm_chunkwise(q, k, v, i_pre, jax.nn.log_sigmoid(f_pre))
    h = h * lax.rsqrt(jnp.mean(jnp.square(h), axis=-1, keepdims=True) + RMS_EPS)
    h = h.reshape(bsz, s, M_V) * norm_g
    return (jax.nn.sigmoid(o) * h.astype(x.dtype)) @ w_out


def memory_attention(x, mem, wq, wk, wv, wo):
    bsz, s, _ = x.shape
    q = (x @ wq).reshape(bsz, s, X_HEADS, X_HEAD_DIM)
    k = (mem @ wk).reshape(bsz, -1, X_HEADS, X_HEAD_DIM)
    v = (mem @ wv).reshape(bsz, -1, X_HEADS, X_HEAD_DIM)
    sc = jnp.einsum('bshd,bmhd->bhsm', q, k).astype(jnp.float32) * (X_HEAD_DIM ** -0.5)
    p = jax.nn.softmax(sc, axis=-1).astype(x.dtype)
    o = jnp.einsum('bhsm,bmhd->bshd', p, v).reshape(bsz, s, D_MODEL)
    return o @ wo


def moe(x, w_router, b_router, w1, b1, w2, b2):
    bsz, s, _ = x.shape
    t = x.reshape(-1, D_MODEL)
    logits = (t @ w_router + b_router).astype(jnp.float32)
    top_val, top_idx = lax.top_k(logits, TOP_K)
    top_w = jax.nn.softmax(top_val, axis=-1)
    combine = jnp.sum(jax.nn.one_hot(top_idx, N_EXPERTS, dtype=jnp.float32) * top_w[..., None], axis=1)
    combine = combine.astype(x.dtype)
    y = jnp.zeros_like(t)
    for e in range(N_EXPERTS):
        gu = t @ w1[e] + b1[e]
        gate = jnp.minimum(gu[:, :D_FF], SWIGLU_LIMIT)
        up = jnp.clip(gu[:, D_FF:], -SWIGLU_LIMIT, SWIGLU_LIMIT)
        hid = (up + 1.0) * gate * jax.nn.sigmoid(SWIGLU_ALPHA * gate)
        y = y + combine[:, e:e + 1] * (hid @ w2[e] + b2[e])
    return y.reshape(bsz, s, D_MODEL)


def setup_inputs(seed: int = 0) -> dict:
    key = jax.random.key(seed)
    keys = iter(jax.random.split(key, 32))

    def nrm(shape, scale):
        return jax.random.normal(next(keys), shape, jnp.float32) * scale

    x = nrm((BATCH, SEQ, D_MODEL), 1.0)
    mem = nrm((BATCH, N_MEM, D_MODEL), 1.0)
    ev_w_in = nrm((N_EVEN, D_MODEL, EV_IN), D_MODEL ** -0.5)
    ev_conv_a = nrm((N_EVEN, A_CONV, A_WIDTH), A_CONV ** -0.5)
    ev_conv_b = nrm((N_EVEN, B_CONV, B_WIDTH), B_CONV ** -0.5)
    ev_conv_b_bias = nrm((N_EVEN, B_WIDTH), 0.01)
    ev_w_rgate = nrm((N_EVEN, B_HEADS, B_HEAD_DIM, B_HEAD_DIM), B_HEAD_DIM ** -0.5)
    ev_b_rgate = nrm((N_EVEN, B_WIDTH), 0.01)
    ev_w_igate = nrm((N_EVEN, B_HEADS, B_HEAD_DIM, B_HEAD_DIM), B_HEAD_DIM ** -0.5)
    ev_b_igate = nrm((N_EVEN, B_WIDTH), 0.01)
    a_pow = jax.random.uniform(next(keys), (N_EVEN, B_WIDTH), jnp.float32, 0.9, 0.999)
    a_base = a_pow ** (1.0 / LRU_C)
    ev_lambda = jnp.log(a_base) - jnp.log1p(-a_base)
    ev_w_out = nrm((N_EVEN, A_WIDTH + B_WIDTH, D_MODEL), (A_WIDTH + B_WIDTH) ** -0.5 * DN_BETA)
    od_w_in = nrm((N_ODD, D_MODEL, OD_IN), D_MODEL ** -0.5)
    f_bias = jnp.linspace(3.0, 6.0, M_HEADS, dtype=jnp.float32)
    od_b_gates = jnp.concatenate([nrm((N_ODD, M_HEADS), 0.1), f_bias + nrm((N_ODD, M_HEADS), 0.1)], axis=-1)
    od_norm_g = 1.0 + nrm((N_ODD, M_V), 0.02)
    od_w_out = nrm((N_ODD, M_V, D_MODEL), M_V ** -0.5 * DN_BETA)
    xa_wq = nrm((DEPTH, D_MODEL, D_MODEL), D_MODEL ** -0.5)
    xa_wk = nrm((DEPTH, D_MODEL, D_MODEL), D_MODEL ** -0.5)
    xa_wv = nrm((DEPTH, D_MODEL, D_MODEL), D_MODEL ** -0.5)
    xa_wo = nrm((DEPTH, D_MODEL, D_MODEL), D_MODEL ** -0.5 * DN_BETA)
    moe_w_router = nrm((DEPTH, D_MODEL, N_EXPERTS), D_MODEL ** -0.5)
    moe_b_router = nrm((DEPTH, N_EXPERTS), 0.01)
    moe_w1 = nrm((DEPTH, N_EXPERTS, D_MODEL, 2 * D_FF), D_MODEL ** -0.5)
    moe_b1 = nrm((DEPTH, N_EXPERTS, 2 * D_FF), 0.01)
    moe_w2 = nrm((DEPTH, N_EXPERTS, D_FF, D_MODEL), D_FF ** -0.5 * DN_BETA)
    moe_b2 = nrm((DEPTH, N_EXPERTS, D_MODEL), 0.01)
    ln_g = 1.0 + nrm((DEPTH, 3, D_MODEL), 0.02)
    ln_b = nrm((DEPTH, 3, D_MODEL), 0.01)
    return {'x': x, 'mem': mem,
            'ev_w_in': ev_w_in, 'ev_conv_a': ev_conv_a, 'ev_conv_b': ev_conv_b,
            'ev_conv_b_bias': ev_conv_b_bias, 'ev_w_rgate': ev_w_rgate, 'ev_b_rgate': ev_b_rgate,
            'ev_w_igate': ev_w_igate, 'ev_b_igate': ev_b_igate, 'ev_lambda': ev_lambda,
            'ev_w_out': ev_w_out,
            'od_w_in': od_w_in, 'od_b_gates': od_b_gates, 'od_norm_g': od_norm_g, 'od_w_out': od_w_out,
            'xa_wq': xa_wq, 'xa_wk': xa_wk, 'xa_wv': xa_wv, 'xa_wo': xa_wo,
            'moe_w_router': moe_w_router, 'moe_b_router': moe_b_router, 'moe_w1': moe_w1,
            'moe_b1': moe_b1, 'moe_w2': moe_w2, 'moe_b2': moe_b2,
            'ln_g': ln_g, 'ln_b': ln_b}


def reference(x, mem, ev_w_in, ev_conv_a, ev_conv_b, ev_conv_b_bias, ev_w_rgate, ev_b_rgate,
              ev_w_igate, ev_b_igate, ev_lambda, ev_w_out, od_w_in, od_b_gates, od_norm_g, od_w_out,
              xa_wq, xa_wk, xa_wv, xa_wo, moe_w_router, moe_b_router, moe_w1, moe_b1, moe_w2, moe_b2,
              ln_g, ln_b):
    for layer in range(DEPTH):
        j = layer // 2
        if layer % 2 == 0:
            mix = even_mixer(x, ev_w_in[j], ev_conv_a[j], ev_conv_b[j], ev_conv_b_bias[j],
                             ev_w_rgate[j], ev_b_rgate[j], ev_w_igate[j], ev_b_igate[j],
                             ev_lambda[j], ev_w_out[j])
        else:
            mix = odd_mixer(x, od_w_in[j], od_b_gates[j], od_norm_g[j], od_w_out[j])
        x = layer_norm(DN_ALPHA * x + mix, ln_g[layer, 0], ln_b[layer, 0])
        att = memory_attention(x, mem, xa_wq[layer], xa_wk[layer], xa_wv[layer], xa_wo[layer])
        x = layer_norm(DN_ALPHA * x + att, ln_g[layer, 1], ln_b[layer, 1])
        ffn = moe(x, moe_w_router[layer], moe_b_router[layer], moe_w1[layer], moe_b1[layer],
                  moe_w2[layer], moe_b2[layer])
        x = layer_norm(DN_ALPHA * x + ffn, ln_g[layer, 2], ln_b[layer, 2])
    return x
```

```cpp
#include <hip/hip_runtime.h>
#include <cstdio>
#include <cstdint>

#ifndef MK_N_LAUNCHES
#define MK_N_LAUNCHES 1
#endif

#define GAS __attribute__((address_space(1)))
#define LAS __attribute__((address_space(3)))
typedef unsigned short bf16;
typedef short bf16x8 __attribute__((ext_vector_type(8)));
typedef float f32x2 __attribute__((ext_vector_type(2)));
typedef float f32x4 __attribute__((ext_vector_type(4)));
typedef float f32x16 __attribute__((ext_vector_type(16)));
typedef unsigned u32x2 __attribute__((ext_vector_type(2)));
typedef unsigned u32x4 __attribute__((ext_vector_type(4)));
typedef int i32x4 __attribute__((ext_vector_type(4)));
typedef int i32x8 __attribute__((ext_vector_type(8)));
typedef GAS unsigned gu32;
#define RLX_AGENT __ATOMIC_RELAXED, __HIP_MEMORY_SCOPE_AGENT
#define LDS_WAIT() asm volatile("s_waitcnt lgkmcnt(0)" ::: "memory")
#define VM_WAIT() asm volatile("s_waitcnt vmcnt(0)" ::: "memory")
#define WG_BAR() do { asm volatile("s_waitcnt lgkmcnt(0)" ::: "memory"); __builtin_amdgcn_s_barrier(); asm volatile("" ::: "memory"); } while (0)

constexpr int T = 65536, D = 1024, SEQ = 4096, NBATCH = 16, NMEM = 256, DEPTH = 4;
constexpr int EV_IN = 3584, OD_IN = 3080, OD_INP = 3072, EV_Y = 1536;
constexpr int NEXP = 32, DFF = 1024;
constexpr float DN_ALPHA = 1.6817928305074290f;
constexpr float LN_EPS = 1e-5f, RMS_EPS = 1e-6f;
constexpr float XR_SCALE = 4096.0f, XR_INV = 1.0f / 4096.0f;
constexpr float W1_SCALE = 64.0f, W2_SCALE = 128.0f, WQ_SCALE = 64.0f, WO_SCALE = 128.0f, O8_SCALE = 8.0f, EO_SCALE = 4.0f, M1_SCALE = 2.0f, M2_SCALE = 4.0f;
constexpr int MAXMT = 1056;

__device__ __forceinline__ unsigned cvt_pk_bf16(float lo, float hi) { unsigned r; asm("v_cvt_pk_bf16_f32 %0, %1, %2" : "=v"(r) : "v"(lo), "v"(hi)); return r; }
__device__ __forceinline__ unsigned cvt_pk4_fp8(float a, float b, float c, float d) { int p = __builtin_amdgcn_cvt_pk_fp8_f32(a, b, 0, false); p = __builtin_amdgcn_cvt_pk_fp8_f32(c, d, p, true); return (unsigned)p; }
__device__ __forceinline__ float bf_lo(unsigned w) { return __uint_as_float(w << 16); }
__device__ __forceinline__ float bf_hi(unsigned w) { return __uint_as_float(w & 0xffff0000u); }
__device__ __forceinline__ float bf1(bf16 v) { return __uint_as_float(((unsigned)v) << 16); }
__device__ __forceinline__ float fsigmoid(float x) { return __builtin_amdgcn_rcpf(1.0f + __expf(-x)); }
#define DPP_F(v, ctrl) __builtin_bit_cast(float, __builtin_amdgcn_update_dpp(0, __builtin_bit_cast(int, (v)), (ctrl), 0xf, 0xf, true))
__device__ __forceinline__ float row16_sum(float v) { v += DPP_F(v, 0xB1); v += DPP_F(v, 0x4E); v += DPP_F(v, 0x141); v += DPP_F(v, 0x140); return v; }
__device__ __forceinline__ float rdlane(float v, int l) { return __builtin_bit_cast(float, __builtin_amdgcn_readlane(__builtin_bit_cast(int, v), l)); }
__device__ __forceinline__ float wave_sum(float v) { v = row16_sum(v); return (rdlane(v, 0) + rdlane(v, 16)) + (rdlane(v, 32) + rdlane(v, 48)); }

__device__ __forceinline__ int lane_id_opaque() { int l; asm volatile("v_mbcnt_lo_u32_b32 %0, -1, 0\n\tv_mbcnt_hi_u32_b32 %0, -1, %0" : "=v"(l)); return l; }
namespace pg8 {
constexpr int BM = 256, BK = 64, HALF = 128, HTB = HALF * BK * 2, STAGE_BYTES = 8 * HTB, NXCD = 8, WGM = 8;
__host__ __device__ __forceinline__ int lds_byte(int r, int c) { const int st = (r >> 4) * 2 + (c >> 5), rr = r & 15, cc = c & 31, ob = rr * 64 + cc * 2; return st * 1024 + (ob ^ (((ob >> 9) & 1) << 5)); }
__host__ __device__ __forceinline__ void stage_rc(int b, int& R, int& C) { const int st = b / 1024, sb = b % 1024, swz = sb ^ (((sb >> 9) & 1) << 5); R = (st >> 1) * 16 + swz / 64; C = (st & 1) * 32 + (swz % 64) / 2; }
__host__ __device__ __forceinline__ int perm32(int rho) { const int n = rho >> 4, i = rho & 15; return 8 * (i >> 2) + 4 * n + (i & 3); }

struct Unit { const char* a; const char* b; int pm, pn, z; };
struct Gemm { int lda, ldb, K; const int* gidx = nullptr; };

__device__ __forceinline__ bool static_map(long L, int nM, int nN, int& pm, int& pn) {
    const int nwg = nM * nN; if (L >= nwg) return false;
    int wgid = (int)L; { const int q = nwg / NXCD, r = nwg % NXCD, xcd = wgid % NXCD, off = wgid / NXCD; wgid = (xcd < r ? xcd * (q + 1) : r * (q + 1) + (xcd - r) * q) + off; }
    const int nig = WGM * nN, gid = wgid / nig, fm = gid * WGM, gsz = (nM - fm) < WGM ? (nM - fm) : WGM;
    pm = fm + ((wgid % nig) % gsz); pn = (wgid % nig) / gsz; return true;
}

template <class Epi, class Sched, bool F8 = false, bool GA = false>
__device__ __forceinline__ void gemm_phase(LAS unsigned char* lds, const Gemm g, const Sched& S, const Epi& E, int wave) {
    const int lane = lane_id_opaque(), wid = wave, tid = wid * 64 + lane,
              wr = wid >> 2, wc = wid & 3, fr = lane & 15, fq = lane >> 4;
    int K_ = g.K; asm volatile("" : "+s"(K_));
    const int K = K_, nt = K / BK;
    unsigned voffA[2], voffB[2]; int RA[2]; unsigned CB[2];
#pragma unroll
    for (int i = 0; i < 2; ++i) { int R, C; stage_rc(tid * 16 + i * 8192, R, C); const int Rb = Epi::PERM ? ((R & ~31) + perm32(R & 31)) : R;
        voffA[i] = (unsigned)(R * g.lda + C) * 2u; voffB[i] = (unsigned)(Rb * g.ldb + C) * 2u; RA[i] = R; CB[i] = (unsigned)C * 2u; }
    const unsigned rowb = (unsigned)g.lda * 2u;
    unsigned vG[2][2], vGN[2][2];
    LAS unsigned char* const gslot = lds + STAGE_BYTES + 8192;
    const size_t kstep = (size_t)(BK * 2);
    const size_t hstepA = (size_t)HALF * g.lda * 2, hstepB = (size_t)HALF * g.ldb * 2;
    const unsigned ldsw = (unsigned)wid * 1024u;
    const int aoff = lds_byte(wr * 64 + fr, fq * 8), boff = lds_byte(wc * 32 + fr, fq * 8);
#define PG8_SA(b, h) (((b) * 2 + (h)) * HTB)
#define PG8_SB(b, h) ((4 + (b) * 2 + (h)) * HTB)
#define PG8_STAGE(bufoff, gbase, voff) do { _Pragma("unroll") for (int _i = 0; _i < 2; ++_i) \
        __builtin_amdgcn_global_load_lds((const unsigned*)((const char*)(gbase) + (voff)[_i]), (LAS unsigned*)(lds + (bufoff) + ldsw + _i * 8192), 16, 0, 0); } while (0)
#define PG8_LDA(dst, b, h) do { _Pragma("unroll") for (int m = 0; m < 4; ++m) _Pragma("unroll") for (int k = 0; k < 2; ++k) dst[m][k] = *(const LAS bf16x8*)(lds + PG8_SA(b, h) + aoff + m * 2048 + k * 1024); } while (0)
#define PG8_LDB(dst, b, h) do { _Pragma("unroll") for (int n = 0; n < 2; ++n) _Pragma("unroll") for (int k = 0; k < 2; ++k) dst[n][k] = *(const LAS bf16x8*)(lds + PG8_SB(b, h) + boff + n * 2048 + k * 1024); } while (0)
#define PG8_CAT(x) __builtin_shufflevector(__builtin_bit_cast(i32x4, (x)[0]), __builtin_bit_cast(i32x4, (x)[1]), 0, 1, 2, 3, 4, 5, 6, 7)
#define PG8_MMA(ai, bj, At, Bt) do { __builtin_amdgcn_s_setprio(1); \
        if constexpr (F8) { _Pragma("unroll") for (int m = 0; m < 4; ++m) _Pragma("unroll") for (int n = 0; n < 2; ++n) \
            asm volatile("v_mfma_scale_f32_16x16x128_f8f6f4 %0, %1, %2, %0, %3, %3 op_sel_hi:[0,0,0]" : "+v"(acc[ai][bj][m][n]) : "v"(PG8_CAT(Bt[n])), "v"(PG8_CAT(At[m])), "v"(f8one)); } \
        else { _Pragma("unroll") for (int m = 0; m < 4; ++m) _Pragma("unroll") for (int n = 0; n < 2; ++n) _Pragma("unroll") for (int k = 0; k < 2; ++k) \
            acc[ai][bj][m][n] = __builtin_amdgcn_mfma_f32_16x16x32_bf16(Bt[n][k], At[m][k], acc[ai][bj][m][n], 0, 0, 0); } \
        __builtin_amdgcn_s_setprio(0); } while (0)
#define PG8_WAIT_V(n) asm volatile("s_waitcnt vmcnt(" #n ")" ::: "memory")
#define PG8_WAIT_L(n) asm volatile("s_waitcnt lgkmcnt(" #n ")" ::: "memory")
#define PG8_BAR __builtin_amdgcn_s_barrier()
#define PG8_SCHED __builtin_amdgcn_sched_barrier(0)
    Unit cur, nxt; int ui = 0;
    if (!S.next(0, cur)) return;
    f32x4 acc[2][2][4][2];
#pragma unroll
    for (int a = 0; a < 2; ++a)
#pragma unroll
        for (int b = 0; b < 2; ++b)
#pragma unroll
            for (int m = 0; m < 4; ++m)
#pragma unroll
                for (int n = 0; n < 2; ++n) acc[a][b][m][n] = (f32x4){0.f, 0.f, 0.f, 0.f};
    bf16x8 At[4][2], B0[2][2], B1[2][2];
    const int f8one = 0x7f7f7f7f;
    const char* cA = cur.a; const char* cB = cur.b;
    if constexpr (Epi::LDSBIAS) E.stage_bias(cur, lds + STAGE_BYTES + 4608, wid, lane);
    if constexpr (GA) {
#pragma unroll
        for (int h = 0; h < 2; ++h)
#pragma unroll
            for (int i = 0; i < 2; ++i) { vG[h][i] = (unsigned)g.gidx[(size_t)cur.pm * 256 + 128 * h + RA[i]] * rowb + CB[i]; vGN[h][i] = vG[h][i]; } }
#define PG8_STAGE_A(bufoff, gbase, h, vg) do { if constexpr (GA) PG8_STAGE(bufoff, gbase, (vg)[h]); else PG8_STAGE(bufoff, (gbase) + (h) * hstepA, voffA); } while (0)
    PG8_STAGE(PG8_SB(0, 0), cB, voffB); PG8_STAGE(PG8_SB(0, 1), cB + hstepB, voffB); PG8_STAGE_A(PG8_SA(0, 0), cA, 0, vG); PG8_STAGE_A(PG8_SA(0, 1), cA, 1, vG);
    if (wr == 1) PG8_BAR;
    PG8_WAIT_V(2); PG8_BAR;
    PG8_STAGE(PG8_SB(1, 0), cB + kstep, voffB); PG8_STAGE_A(PG8_SA(1, 0), cA + kstep, 0, vG); PG8_STAGE(PG8_SB(1, 1), cB + hstepB + kstep, voffB);
    PG8_WAIT_V(6); PG8_BAR;
    for (;;) {
        const bool has_next = S.next(ui + 1, nxt);
        const char* nA = has_next ? nxt.a : cA; const char* nB = has_next ? nxt.b : cB;
        if constexpr (Epi::LDSBIAS) { if (ui > 0) E.stage_bias(cur, lds + STAGE_BYTES + 4608 + (ui & 1) * 1024, wid, lane); }
        if constexpr (GA) { if (has_next && wid == 1) __builtin_amdgcn_global_load_lds((const unsigned*)(g.gidx + (size_t)nxt.pm * 256 + 4 * lane), (LAS unsigned*)(gslot + ((ui + 1) & 1) * 1024), 16, 0, 0); }
#pragma clang loop unroll(disable)
        for (int t = 0; t < nt; t += 2) {
            const bool last = (t == nt - 2);
            const char* a1 = cA + (size_t)(t + 1) * kstep;
            const char* a2 = last ? nA : cA + (size_t)(t + 2) * kstep; const char* b2 = last ? nB : cB + (size_t)(t + 2) * kstep;
            const char* a3 = a2 + kstep; const char* b3 = b2 + kstep;
            unsigned vS[2][2];
            if constexpr (GA) {
                if (last && has_next) { const LAS int* ix = (const LAS int*)(gslot + ((ui + 1) & 1) * 1024);
#pragma unroll
                    for (int h = 0; h < 2; ++h)
#pragma unroll
                        for (int i = 0; i < 2; ++i) vGN[h][i] = (unsigned)ix[128 * h + RA[i]] * rowb + CB[i]; }
#pragma unroll
                for (int h = 0; h < 2; ++h)
#pragma unroll
                    for (int i = 0; i < 2; ++i) vS[h][i] = last ? vGN[h][i] : vG[h][i]; }
            PG8_LDB(B0, 0, 0); PG8_LDB(B1, 0, 1); PG8_SCHED; PG8_LDA(At, 0, 0); PG8_STAGE_A(PG8_SA(1, 1), a1, 1, vG);
            PG8_WAIT_V(8); PG8_WAIT_L(0); PG8_BAR; PG8_MMA(0, 0, At, B0); PG8_MMA(0, 1, At, B1); PG8_BAR; PG8_SCHED;
            PG8_LDA(At, 0, 1); PG8_STAGE(PG8_SB(0, 0), b2, voffB); PG8_STAGE(PG8_SB(0, 1), b2 + hstepB, voffB); PG8_STAGE_A(PG8_SA(0, 0), a2, 0, vS);
            PG8_WAIT_V(8); PG8_WAIT_L(0); PG8_BAR; PG8_MMA(1, 0, At, B0); PG8_MMA(1, 1, At, B1); PG8_BAR; PG8_SCHED;
            PG8_LDB(B0, 1, 0); PG8_LDB(B1, 1, 1); PG8_SCHED; PG8_LDA(At, 1, 0); PG8_STAGE_A(PG8_SA(0, 1), a2, 1, vS);
            PG8_WAIT_V(8); PG8_WAIT_L(0); PG8_BAR; PG8_MMA(0, 0, At, B0); PG8_MMA(0, 1, At, B1); PG8_BAR; PG8_SCHED;
            PG8_LDA(At, 1, 1); PG8_STAGE(PG8_SB(1, 0), b3, voffB); PG8_STAGE(PG8_SB(1, 1), b3 + hstepB, voffB); PG8_STAGE_A(PG8_SA(1, 0), a3, 0, vS);
            PG8_WAIT_V(8); PG8_WAIT_L(0); PG8_BAR; PG8_MMA(1, 0, At, B0); PG8_MMA(1, 1, At, B1); PG8_BAR; PG8_SCHED;
        }
        if constexpr (F8) asm volatile("s_nop 15\n\ts_nop 15" ::: "memory");
        if (wr == 0) PG8_BAR;
        E(acc, cur, wr, wc, fr, fq, Epi::LDSBIAS ? lds + STAGE_BYTES + 4608 + (ui & 1) * 1024 : lds + STAGE_BYTES);
        if (!has_next) break;
#pragma unroll
        for (int a = 0; a < 2; ++a)
#pragma unroll
            for (int b = 0; b < 2; ++b)
#pragma unroll
                for (int m = 0; m < 4; ++m)
#pragma unroll
                    for (int n = 0; n < 2; ++n) acc[a][b][m][n] = (f32x4){0.f, 0.f, 0.f, 0.f};
        cur = nxt; cA = nA; cB = nB; ++ui;
        if constexpr (GA) {
#pragma unroll
            for (int h = 0; h < 2; ++h)
#pragma unroll
                for (int i = 0; i < 2; ++i) vG[h][i] = vGN[h][i]; }
        if (wr == 1) PG8_BAR;
    }
    PG8_WAIT_V(0);
    PG8_BAR;
#undef PG8_SA
#undef PG8_SB
#undef PG8_STAGE
#undef PG8_STAGE_A
#undef PG8_LDA
#undef PG8_LDB
#undef PG8_MMA
#undef PG8_CAT
#undef PG8_WAIT_V
#undef PG8_WAIT_L
#undef PG8_BAR
#undef PG8_SCHED
}

struct DenseOrder {
    const char* A; const char* B; size_t astep, bstep; int nM, nN, G, c;
    __device__ __forceinline__ bool next(int i, Unit& u) const {
        int pm, pn; if (!static_map((long)i * G + c, nM, nN, pm, pn)) return false;
        u.pm = pm; u.pn = pn; u.z = 0; u.a = A + (size_t)pm * astep; u.b = B + (size_t)pn * bstep; return true; }
};
struct BatchOrder {
    const char* A; const char* B; size_t astep, astep2, bstepm, bstepn; int bshift, nM, nN, G, c;
    __device__ __forceinline__ bool next(int i, Unit& u) const {
        int pm, pn; if (!static_map((long)i * G + c, nM, nN, pm, pn)) return false;
        u.pm = pm; u.pn = pn; u.z = 0; u.a = A + (size_t)pm * astep + (size_t)pn * astep2; u.b = B + (size_t)(pm >> bshift) * bstepm + (size_t)pn * bstepn; return true; }
};
struct StackOrder {
    const char* A; const char* B; size_t astep, bstep, azstep, bzstep; int nM, nN, nZ, G, c;
    __device__ __forceinline__ bool next(int i, Unit& u) const {
        const long L = (long)i * G + c; const int per = nM * nN; if (L >= (long)per * nZ) return false;
        const int z = (int)(L / per); int pm, pn; static_map(L - (long)z * per, nM, nN, pm, pn);
        u.pm = pm; u.pn = pn; u.z = z; u.a = A + (size_t)z * azstep + (size_t)pm * astep; u.b = B + (size_t)z * bzstep + (size_t)pn * bstep; return true; }
};
struct FoldOrder {
    const char* A; const char* B; bool m2; int G, c;
    __device__ __forceinline__ bool next(int i, Unit& u) const {
        const long L = (long)i * G + c; if (L >= 1024) return false;
        const int z = (int)(L >> 2), q = (int)(L & 3), l = z >> 6, b = (z >> 2) & 15, h = z & 3;
        if (!m2) { u.pm = 0; u.pn = q; u.z = z; u.a = A + ((size_t)(l * 4096 + b * 256) * 1024 + h * 256); u.b = B + ((size_t)l * 1024 * 1024 + (size_t)q * 256 * 1024 + h * 256); }
        else     { u.pm = q; u.pn = h; u.z = z >> 2; u.a = A + ((size_t)l * 1024 * 1024 + (size_t)q * 256 * 1024 + h * 256); u.b = B + ((size_t)(l * 4096 + b * 256) * 1024 + h * 256); }
        return true; }
};
struct MoeOrder {
    const char* A; const char* B; size_t astep, bstep_e, bstep_n; const LAS int* tile_e; int nM, nN, G, c;
    __device__ __forceinline__ bool next(int i, Unit& u) const {
        int pm, pn; if (!static_map((long)i * G + c, nM, nN, pm, pn)) return false;
        const int e = __builtin_amdgcn_readfirstlane(tile_e[pm]);
        u.pm = pm; u.pn = pn; u.z = e; u.a = A + (size_t)pm * astep; u.b = B + (size_t)e * bstep_e + (size_t)pn * bstep_n; return true; }
};

struct EpiStore {
    static constexpr bool PERM = true, INPLACE = false, LDSBIAS = false;
    bf16* O; int ldc; size_t zstride; const float* bias; int bzs; float scale; int scale_tiles; float accs = 1.0f;
    __device__ __forceinline__ void operator()(f32x4 (&acc)[2][2][4][2], const Unit& u, int wr, int wc, int fr, int fq, LAS unsigned char*) const {
        const int row0 = u.pm * BM + wr * 64 + fr, col0 = u.pn * BM + wc * 32 + 8 * fq;
        bf16* base = O + (size_t)u.z * zstride;
        const float sc = (u.pn < scale_tiles) ? scale : 1.0f;
        f32x4 bv[2][2];
#pragma unroll
        for (int bj = 0; bj < 2; ++bj)
#pragma unroll
            for (int n = 0; n < 2; ++n) bv[bj][n] = bias ? *(const f32x4*)(bias + (size_t)u.z * bzs + col0 + bj * HALF + 4 * n) : (f32x4){0.f, 0.f, 0.f, 0.f};
#pragma unroll
        for (int ai = 0; ai < 2; ++ai)
#pragma unroll
            for (int m = 0; m < 4; ++m) { bf16* rowp = base + (size_t)(row0 + ai * HALF + m * 16) * ldc + col0;
#pragma unroll
                for (int bj = 0; bj < 2; ++bj) { const f32x4 v0 = (acc[ai][bj][m][0] * accs + bv[bj][0]) * sc, v1 = (acc[ai][bj][m][1] * accs + bv[bj][1]) * sc;
                    u32x4 w; w.x = cvt_pk_bf16(v0[0], v0[1]); w.y = cvt_pk_bf16(v0[2], v0[3]); w.z = cvt_pk_bf16(v1[0], v1[1]); w.w = cvt_pk_bf16(v1[2], v1[3]);
                    *(u32x4*)(rowp + bj * HALF) = w; } }
    }
};
template <bool LB> struct EpiStore8T {
    static constexpr bool PERM = true, INPLACE = false, LDSBIAS = LB;
    unsigned char* O; int ldc; float scale; const float* bias = nullptr; int bzs = 0; float accs = 1.0f; size_t zstride = 0;
    __device__ __forceinline__ void stage_bias(const Unit& u, LAS unsigned char* slot, int wid, int lane) const {
        if (wid == 0) __builtin_amdgcn_global_load_lds((const unsigned*)(bias + (size_t)u.z * bzs + u.pn * BM + 4 * lane), (LAS unsigned*)slot, 16, 0, 0); }
    __device__ __forceinline__ void operator()(f32x4 (&acc)[2][2][4][2], const Unit& u, int wr, int wc, int fr, int fq, LAS unsigned char* xl) const {
        const int row0 = u.pm * BM + wr * 64 + fr, col0 = u.pn * BM + wc * 32 + 8 * fq;
        f32x4 bv[2][2];
#pragma unroll
        for (int bj = 0; bj < 2; ++bj)
#pragma unroll
            for (int n = 0; n < 2; ++n) { if constexpr (LB) bv[bj][n] = *(const LAS f32x4*)(xl + (wc * 32 + 8 * fq + bj * HALF + 4 * n) * 4);
                else bv[bj][n] = bias ? *(const f32x4*)(bias + (size_t)u.z * bzs + col0 + bj * HALF + 4 * n) : (f32x4){0.f, 0.f, 0.f, 0.f}; }
#pragma unroll
        for (int ai = 0; ai < 2; ++ai)
#pragma unroll
            for (int m = 0; m < 4; ++m) { unsigned char* rowp = O + (size_t)u.z * zstride + (size_t)(row0 + ai * HALF + m * 16) * ldc + col0;
#pragma unroll
                for (int bj = 0; bj < 2; ++bj) { const f32x4 v0 = (acc[ai][bj][m][0] * accs + bv[bj][0]) * scale, v1 = (acc[ai][bj][m][1] * accs + bv[bj][1]) * scale;
                    u32x2 w; w.x = cvt_pk4_fp8(v0[0], v0[1], v0[2], v0[3]); w.y = cvt_pk4_fp8(v1[0], v1[1], v1[2], v1[3]);
                    *(u32x2*)(rowp + bj * HALF) = w; } }
    }
};
typedef EpiStore8T<false> EpiStore8;
struct EpiSwiglu {
    static constexpr bool PERM = true, INPLACE = false, LDSBIAS = true;
    unsigned char* HID; const float* b1; float accs;
    __device__ __forceinline__ void stage_bias(const Unit& u, LAS unsigned char* slot, int wid, int lane) const {
        if (wid == 0) __builtin_amdgcn_global_load_lds((const unsigned*)(b1 + (size_t)u.z * 2048 + (lane >> 5) * 1024 + u.pn * 128 + 4 * (lane & 31)), (LAS unsigned*)slot, 16, 0, 0); }
    __device__ __forceinline__ void operator()(f32x4 (&acc)[2][2][4][2], const Unit& u, int wr, int wc, int fr, int fq, LAS unsigned char* xl) const {
        const int row0 = u.pm * BM + wr * 64 + fr, j0 = u.pn * 128 + wc * 32 + 8 * fq;
        f32x4 bgv[2], buv[2];
#pragma unroll
        for (int n = 0; n < 2; ++n) { bgv[n] = *(const LAS f32x4*)(xl + (wc * 32 + 8 * fq + 4 * n) * 4); buv[n] = *(const LAS f32x4*)(xl + (128 + wc * 32 + 8 * fq + 4 * n) * 4); }
#pragma unroll
        for (int ai = 0; ai < 2; ++ai)
#pragma unroll
            for (int m = 0; m < 4; ++m) { float h[8];
#pragma unroll
                for (int n = 0; n < 2; ++n) { const f32x4 gt = acc[ai][0][m][n] * accs + bgv[n], up = acc[ai][1][m][n] * accs + buv[n];
#pragma unroll
                    for (int q = 0; q < 4; ++q) { const float gc = fminf(gt[q], 7.0f), uc = fminf(fmaxf(up[q], -7.0f), 7.0f); h[4 * n + q] = (uc + 1.0f) * gc * fsigmoid(1.702f * gc); } }
                u32x2 w; w.x = cvt_pk4_fp8(h[0], h[1], h[2], h[3]); w.y = cvt_pk4_fp8(h[4], h[5], h[6], h[7]);
                *(u32x2*)(HID + (size_t)(row0 + ai * HALF + m * 16) * DFF + j0) = w; }
    }
};
struct EpiSoftmax {
    static constexpr bool PERM = true, INPLACE = true, LDSBIAS = false;
    unsigned char* P; float sscale;
    __device__ __forceinline__ void operator()(f32x4 (&acc)[2][2][4][2], const Unit& u, int wr, int wc, int fr, int fq, LAS unsigned char* xl) const {
        LAS f32x2* X = (LAS f32x2*)xl;
#pragma unroll
        for (int ai = 0; ai < 2; ++ai)
#pragma unroll
            for (int bj = 0; bj < 2; ++bj)
#pragma unroll
                for (int m = 0; m < 4; ++m)
#pragma unroll
                    for (int n = 0; n < 2; ++n) acc[ai][bj][m][n] = acc[ai][bj][m][n] * sscale;
        float mw[2][4];
#pragma unroll
        for (int ai = 0; ai < 2; ++ai)
#pragma unroll
            for (int m = 0; m < 4; ++m) { float mx = -3.0e38f;
#pragma unroll
                for (int bj = 0; bj < 2; ++bj)
#pragma unroll
                    for (int n = 0; n < 2; ++n) { const f32x4 x = acc[ai][bj][m][n]; mx = fmaxf(mx, fmaxf(fmaxf(x[0], x[1]), fmaxf(x[2], x[3]))); }
                mx = fmaxf(mx, __shfl_xor(mx, 16)); mx = fmaxf(mx, __shfl_xor(mx, 32));
                float s = 0.f;
#pragma unroll
                for (int bj = 0; bj < 2; ++bj)
#pragma unroll
                    for (int n = 0; n < 2; ++n)
#pragma unroll
                        for (int q = 0; q < 4; ++q) { const float e = __expf(acc[ai][bj][m][n][q] - mx); acc[ai][bj][m][n][q] = e; s += e; }
                s += __shfl_xor(s, 16); s += __shfl_xor(s, 32);
                mw[ai][m] = mx;
                if (fq == 0) X[(ai * HALF + wr * 64 + m * 16 + fr) * 4 + wc] = (f32x2){mx, s};
            }
        asm volatile("s_waitcnt lgkmcnt(0)" ::: "memory"); __builtin_amdgcn_s_barrier(); asm volatile("" ::: "memory");
        const int row0 = u.pm * BM + wr * 64 + fr, col0 = u.pn * BM + wc * 32 + 8 * fq;
#pragma unroll
        for (int ai = 0; ai < 2; ++ai)
#pragma unroll
            for (int m = 0; m < 4; ++m) { const int r = ai * HALF + wr * 64 + m * 16 + fr;
                const f32x2 a = X[r * 4 + 0], b = X[r * 4 + 1], c = X[r * 4 + 2], d = X[r * 4 + 3];
                const float mt = fmaxf(fmaxf(a.x, b.x), fmaxf(c.x, d.x));
                const float st = a.y * __expf(a.x - mt) + b.y * __expf(b.x - mt) + c.y * __expf(c.x - mt) + d.y * __expf(d.x - mt);
                const float sc = __expf(mw[ai][m] - mt) * __builtin_amdgcn_rcpf(st) * 256.0f;
                unsigned char* rowp = P + (size_t)(row0 + ai * HALF + m * 16) * D + col0;
#pragma unroll
                for (int bj = 0; bj < 2; ++bj) { const f32x4 e0 = acc[ai][bj][m][0] * sc, e1 = acc[ai][bj][m][1] * sc;
                    u32x2 w; w.x = cvt_pk4_fp8(e0[0], e0[1], e0[2], e0[3]); w.y = cvt_pk4_fp8(e1[0], e1[1], e1[2], e1[3]);
                    *(u32x2*)(rowp + bj * HALF) = w; } }
    }
};
}

constexpr size_t MiB = 1u << 20;
constexpr size_t WS_CTL = 0, CTL_ZERO_BYTES = 1 * MiB;
constexpr size_t WS_TOPI = 1 * MiB, WS_TOPW = 2 * MiB, WS_POSMAP = 3 * MiB, WS_GATES = 4 * MiB  , WS_CNT = 6 * MiB  , WS_TILEE = 7 * MiB  , WS_K2 = 8 * MiB  , WS_WRT = 9 * MiB  , WS_ROWTOK = 10 * MiB  ;
constexpr size_t WS_W = 16 * MiB;
constexpr size_t W_EVIN = WS_W, W_EVOUT = W_EVIN + 14 * MiB, W_GATE = W_EVOUT + 6 * MiB, W_ODIN = W_GATE + 1 * MiB, W_ODOUT = W_ODIN + 12 * MiB;
constexpr size_t W_Q = W_ODOUT + 4 * MiB, W_K = W_Q + 8 * MiB, W_V = W_K + 8 * MiB, W_O = W_V + 8 * MiB, W_1 = W_O + 8 * MiB, W_2 = W_1 + 512 * MiB, W_END = W_2 + 256 * MiB;
static_assert(W_END <= 880 * MiB, "weights");
constexpr size_t WS_MEMB = 880 * MiB, WS_KM = 888 * MiB, WS_VT = 920 * MiB, WS_XB = 960 * MiB, WS_MIX = 1088 * MiB, WS_R = 1216 * MiB, WS_Y = 2316 * MiB, WS_XR8 = 2508 * MiB, WS_M1 = 2572 * MiB, WS_M2 = 2636 * MiB, WS_END = 2700 * MiB;
constexpr size_t R_Z = WS_R, R_U = WS_R + 448 * MiB, R_AG = WS_R + 576 * MiB, R_INP = WS_R + 832 * MiB, R_HB = WS_R + 448 * MiB;
constexpr size_t R_Q = WS_R, R_P = WS_R + 128 * MiB, R_O = WS_R + 256 * MiB, R_XG = WS_R, R_HID = WS_R + 264 * MiB, R_EO = WS_R + 528 * MiB, R_XA8 = WS_R + 320 * MiB;
static_assert(R_EO + 528 * MiB <= WS_Y && (size_t)MAXMT * 256 * 1024 * 2 <= 528 * MiB, "scratch region");
constexpr int CW_BAR = 4096;

constexpr int LDS_BYTES = 147456;
constexpr int XCH_OFF = 131072;
constexpr int MISC_OFF = LDS_BYTES - 256;
constexpr int NWAVES = 8;

#define XB_TMO      128
#define XB_XCNT(j)  (256  + 64 * (j))
#define XB_XSUB(j)  (1280 + 64 * (j))
#define XB_XGEN(j)  (2304 + 64 * (j))
#define XB_TOP      3328
#define XB_TOPGEN   3392
#define XCD_BAR_WORDS 3456
#define XB_SPIN_CAP (1u << 18)
__device__ __forceinline__ unsigned xb_ld(unsigned* p)              { return __hip_atomic_load(p, __ATOMIC_RELAXED, __HIP_MEMORY_SCOPE_AGENT); }
__device__ __forceinline__ unsigned xb_add(unsigned* p, unsigned v) { return __hip_atomic_fetch_add(p, v, __ATOMIC_RELAXED, __HIP_MEMORY_SCOPE_AGENT); }
__device__ __forceinline__ unsigned xb_xcc_id() { return (unsigned)__builtin_amdgcn_s_getreg((3 << 11) | 20) & 0xFu; }
#define XB_SPIN(cond, bar) do { unsigned _sp = 0; while (cond) { __builtin_amdgcn_s_sleep(1); \
    if ((++_sp & 255u) == 0u) { if (xb_ld(&(bar)[XB_TMO])) break; if (_sp > XB_SPIN_CAP) { atomicAdd(&(bar)[XB_TMO], 1u); break; } } } } while (0)
struct XcdBarrier { unsigned* bar; unsigned x; volatile LAS unsigned* st; int wave; };
__device__ __forceinline__ XcdBarrier xcd_barrier_post(unsigned* bar, volatile LAS unsigned* st, int wave) {
    XcdBarrier b; b.bar = bar; b.x = xb_xcc_id(); b.st = st; b.wave = wave;
    if (wave == 0 && lane_id_opaque() == 0) (void)xb_add(&bar[XB_XCNT(b.x)], 1u);
    return b;
}
__device__ __forceinline__ void xcd_barrier_complete(unsigned* bar, unsigned x, unsigned& nloc, unsigned& nx) {
    const unsigned G = gridDim.x * gridDim.y * gridDim.z;
    unsigned sum, cnt, mine, sp = 0u;
    for (;;) {
        sum = 0u; cnt = 0u; mine = 0u;
#pragma unroll
        for (unsigned j = 0; j < 16; ++j) { const unsigned c = xb_ld(&bar[XB_XCNT(j)]); sum += c; cnt += (c > 0u) ? 1u : 0u; mine = (j == x) ? c : mine; }
        if (sum == G) break;
        __builtin_amdgcn_s_sleep(1);
        if ((++sp & 255u) == 0u) { if (xb_ld(&bar[XB_TMO])) break; if (sp > XB_SPIN_CAP) { atomicAdd(&bar[XB_TMO], 1u); break; } }
    }
    nloc = mine > 0u ? mine : 1u; nx = cnt > 0u ? cnt : 1u;
}
__device__ __forceinline__ void xcd_barrier(const XcdBarrier& b) {
    asm volatile("s_waitcnt vmcnt(0)" ::: "memory");
    __syncthreads();
    if (b.wave == 0 && lane_id_opaque() == 0) {
        unsigned* bar = b.bar;
        __builtin_amdgcn_s_waitcnt(0);
        unsigned nloc = b.st[0], nx = b.st[1];
        if (nloc == 0u) { xcd_barrier_complete(bar, b.x, nloc, nx); b.st[0] = nloc; b.st[1] = nx; }
        const unsigned old = xb_add(&bar[XB_XSUB(b.x)], 1u);
        const unsigned gen = old / nloc;
        if (old + 1u == (gen + 1u) * nloc) {
            __builtin_amdgcn_fence(__ATOMIC_RELEASE, "agent");
            asm volatile("s_waitcnt vmcnt(0)" ::: "memory");
            const unsigned og = xb_add(&bar[XB_TOP], 1u);
            const unsigned tg = og / nx;
            if (og + 1u == (tg + 1u) * nx) xb_add(&bar[XB_TOPGEN], 1u);
            else XB_SPIN(xb_ld(&bar[XB_TOPGEN]) == tg, bar);
            __builtin_amdgcn_fence(__ATOMIC_ACQUIRE, "agent");
            xb_add(&bar[XB_XGEN(b.x)], 1u);
            asm volatile("s_waitcnt vmcnt(0)" ::: "memory");
        } else {
            XB_SPIN(xb_ld(&bar[XB_XGEN(b.x)]) == gen, bar);
            __builtin_amdgcn_fence(__ATOMIC_ACQUIRE, "agent");
            asm volatile("s_waitcnt vmcnt(0)" ::: "memory");
        }
    }
    __syncthreads();
}

#define MFMA16(a, b, c) __builtin_amdgcn_mfma_f32_16x16x32_bf16(a, b, c, 0, 0, 0)
__device__ __forceinline__ void unpack8(const u32x4 w, float (&o)[8]) { o[0] = bf_lo(w.x); o[1] = bf_hi(w.x); o[2] = bf_lo(w.y); o[3] = bf_hi(w.y); o[4] = bf_lo(w.z); o[5] = bf_hi(w.z); o[6] = bf_lo(w.w); o[7] = bf_hi(w.w); }
__device__ __forceinline__ u32x4 pack8(const float (&o)[8]) { u32x4 w; w.x = cvt_pk_bf16(o[0], o[1]); w.y = cvt_pk_bf16(o[2], o[3]); w.z = cvt_pk_bf16(o[4], o[5]); w.w = cvt_pk_bf16(o[6], o[7]); return w; }
struct Ctx { LAS unsigned char* lds; int tid, lane, wave, bid, G; };

__device__ __forceinline__ void tr_load(f32x4 (&v)[16], const float* W, int srcN, int k0, int n0, int lane) {
#pragma unroll
    for (int i = 0; i < 16; ++i) v[i] = *(const f32x4*)(W + (size_t)(k0 + 4 * i + (lane >> 4)) * srcN + n0 + 4 * (lane & 15));
}
__device__ __forceinline__ void tr_store(const f32x4 (&v)[16], int k0, bf16* WT, int dstK, int drow0, LAS float* scr, int lane, float f8scale) {
#pragma unroll
    for (int i = 0; i < 16; ++i) { LAS float* d = scr + (4 * i + (lane >> 4)) * 65 + 4 * (lane & 15); d[0] = v[i][0]; d[1] = v[i][1]; d[2] = v[i][2]; d[3] = v[i][3]; }
    LDS_WAIT();
    const int c = lane & 7;
    if (f8scale != 0.f) {
        unsigned char* W8 = (unsigned char*)WT;
#pragma unroll
        for (int j = 0; j < 8; ++j) { const int n = (lane >> 3) + 8 * j; const LAS float* sp = scr + (8 * c) * 65 + n;
            u32x2 o; o.x = cvt_pk4_fp8(sp[0 * 65] * f8scale, sp[1 * 65] * f8scale, sp[2 * 65] * f8scale, sp[3 * 65] * f8scale); o.y = cvt_pk4_fp8(sp[4 * 65] * f8scale, sp[5 * 65] * f8scale, sp[6 * 65] * f8scale, sp[7 * 65] * f8scale);
            *(u32x2*)(W8 + (size_t)(drow0 + n) * dstK + k0 + 8 * c) = o; }
    } else {
#pragma unroll
        for (int j = 0; j < 8; ++j) { const int n = (lane >> 3) + 8 * j; const LAS float* sp = scr + (8 * c) * 65 + n;
            u32x4 o; o.x = cvt_pk_bf16(sp[0 * 65], sp[1 * 65]); o.y = cvt_pk_bf16(sp[2 * 65], sp[3 * 65]); o.z = cvt_pk_bf16(sp[4 * 65], sp[5 * 65]); o.w = cvt_pk_bf16(sp[6 * 65], sp[7 * 65]);
            *(u32x4*)(WT + (size_t)(drow0 + n) * dstK + k0 + 8 * c) = o; }
    }
    LDS_WAIT();
}
__device__ __forceinline__ void conv_group(const Ctx& X, const float* src, int nb, int K, int N, int srcN, size_t sbs, bf16* dst, size_t dbs, int map, float f8scale = 0.f) {
    LAS float* scr = (LAS float*)(X.lds + X.wave * 16896);
    const int gw = X.bid * NWAVES + X.wave, NGW = X.G * NWAVES;
    const int nblk = N / 64, ipb = (K / 64) * nblk; const long total = (long)nb * ipb;
    f32x4 v[16], vn[16];
    long it = gw;
    if (it < total) { const int bt = (int)(it / ipb), r = (int)(it % ipb); tr_load(v, src + (size_t)bt * sbs, srcN, 64 * (r / nblk), 64 * (r % nblk), X.lane); }
    for (; it < total; it += NGW) {
        const int bt = (int)(it / ipb), r = (int)(it % ipb), kb = r / nblk, n0 = 64 * (r % nblk);
        const long itn = it + NGW;
        if (itn < total) { const int btn = (int)(itn / ipb), rn = (int)(itn % ipb); tr_load(vn, src + (size_t)btn * sbs, srcN, 64 * (rn / nblk), 64 * (rn % nblk), X.lane); }
        __builtin_amdgcn_sched_barrier(0);
        int drow = n0; if (map == 1) { const int j = n0 & 1023; drow = (j >> 7) * 256 + (n0 >= 1024 ? 128 : 0) + (j & 127); }
        bf16* dp = f8scale != 0.f ? (bf16*)((unsigned char*)dst + (size_t)bt * dbs) : dst + (size_t)bt * dbs;
        tr_store(v, 64 * kb, dp, K, drow, scr, X.lane, f8scale);
        __builtin_amdgcn_sched_barrier(0);
#pragma unroll
        for (int i = 0; i < 16; ++i) v[i] = vn[i];
    }
}
__device__ __forceinline__ void cvt_flat(const Ctx& X, const float* src, bf16* dst, size_t n) {
    const size_t gt = (size_t)X.bid * 512 + X.tid, NT = (size_t)X.G * 512;
    for (size_t i = gt; i < n / 8; i += NT) { const f32x4 a = *(const f32x4*)(src + i * 8), b = *(const f32x4*)(src + i * 8 + 4);
        u32x4 w; w.x = cvt_pk_bf16(a[0], a[1]); w.y = cvt_pk_bf16(a[2], a[3]); w.z = cvt_pk_bf16(b[0], b[1]); w.w = cvt_pk_bf16(b[2], b[3]); *(u32x4*)(dst + i * 8) = w; }
}

__device__ __forceinline__ void cvt_flat8(const Ctx& X, const float* src, unsigned char* dst, size_t n, float sc = 1.0f) {
    const size_t gt = (size_t)X.bid * 512 + X.tid, NT = (size_t)X.G * 512;
    for (size_t i = gt; i < n / 8; i += NT) { const f32x4 a = *(const f32x4*)(src + i * 8), b = *(const f32x4*)(src + i * 8 + 4);
        u32x2 w; w.x = cvt_pk4_fp8(a[0] * sc, a[1] * sc, a[2] * sc, a[3] * sc); w.y = cvt_pk4_fp8(b[0] * sc, b[1] * sc, b[2] * sc, b[3] * sc); *(u32x2*)(dst + i * 8) = w; }
}

template <bool MOE, int ROWS>
__device__ __forceinline__ void ln_phase(const Ctx& X, const float* xin_f32, const bf16* f, const int* posmap, const float* topw, const float* g, const float* b, float* xout_f32, bf16* xb, unsigned char* xr8, unsigned char* x8 = nullptr) {
    const int gw = X.bid * NWAVES + X.wave, NGW = X.G * NWAVES, lane = X.lane;
    f32x4 gv[4], bv[4];
#pragma unroll
    for (int j = 0; j < 4; ++j) { gv[j] = *(const f32x4*)(g + 4 * lane + 256 * j); bv[j] = *(const f32x4*)(b + 4 * lane + 256 * j); }
    for (int base = gw * ROWS; base < T; base += NGW * ROWS) {
        f32x4 v[ROWS][4];
#pragma unroll
        for (int r = 0; r < ROWS; ++r)
#pragma unroll
            for (int j = 0; j < 4; ++j) { const size_t o_ = (size_t)(base + r) * D + 4 * lane + 256 * j;
                if (xin_f32) v[r][j] = *(const f32x4*)(xin_f32 + o_);
                else { const u32x2 w = *(const u32x2*)(xb + o_); const unsigned q8 = *(const unsigned*)(xr8 + o_);
                    v[r][j] = (f32x4){bf_lo(w.x), bf_hi(w.x), bf_lo(w.y), bf_hi(w.y)} + (f32x4){__builtin_amdgcn_cvt_f32_fp8(q8, 0), __builtin_amdgcn_cvt_f32_fp8(q8, 1), __builtin_amdgcn_cvt_f32_fp8(q8, 2), __builtin_amdgcn_cvt_f32_fp8(q8, 3)} * XR_INV; } }
        if (MOE) {
            const int vz = X.tid >> 10;
            unsigned fw[ROWS][4][4]; f32x4 tw[ROWS];
#pragma unroll
            for (int r = 0; r < ROWS; ++r) { const int4 ps = *(const int4*)(posmap + (size_t)(base + r) * 4 + vz); tw[r] = *(const f32x4*)(topw + (size_t)(base + r) * 4 + vz);
                const int pp[4] = {ps.x, ps.y, ps.z, ps.w};
#pragma unroll
                for (int s = 0; s < 4; ++s)
#pragma unroll
                    for (int j = 0; j < 4; ++j) fw[r][s][j] = *(const unsigned*)((const unsigned char*)f + (size_t)pp[s] * D + 4 * lane + 256 * j); }
#pragma unroll
            for (int r = 0; r < ROWS; ++r)
#pragma unroll
                for (int j = 0; j < 4; ++j) { v[r][j] = v[r][j] * DN_ALPHA;
#pragma unroll
                    for (int s = 0; s < 4; ++s) { const unsigned w = fw[r][s][j]; const float ts = tw[r][s] * (1.0f / EO_SCALE);
                        v[r][j] += (f32x4){__builtin_amdgcn_cvt_f32_fp8(w, 0), __builtin_amdgcn_cvt_f32_fp8(w, 1), __builtin_amdgcn_cvt_f32_fp8(w, 2), __builtin_amdgcn_cvt_f32_fp8(w, 3)} * ts; } }
        } else {
            u32x2 fw[ROWS][4];
#pragma unroll
            for (int r = 0; r < ROWS; ++r)
#pragma unroll
                for (int j = 0; j < 4; ++j) fw[r][j] = *(const u32x2*)(f + (size_t)(base + r) * D + 4 * lane + 256 * j);
#pragma unroll
            for (int r = 0; r < ROWS; ++r)
#pragma unroll
                for (int j = 0; j < 4; ++j) { const u32x2 w = fw[r][j]; v[r][j] = v[r][j] * DN_ALPHA + (f32x4){bf_lo(w.x), bf_hi(w.x), bf_lo(w.y), bf_hi(w.y)}; }
        }
        float mean[ROWS], rstd[ROWS];
#pragma unroll
        for (int r = 0; r < ROWS; ++r) { float s = 0.f;
#pragma unroll
            for (int j = 0; j < 4; ++j) s += (v[r][j][0] + v[r][j][1]) + (v[r][j][2] + v[r][j][3]);
            mean[r] = wave_sum(s) * (1.f / D); }
#pragma unroll
        for (int r = 0; r < ROWS; ++r) { float s2 = 0.f;
#pragma unroll
            for (int j = 0; j < 4; ++j) { v[r][j] = v[r][j] - mean[r]; s2 += (v[r][j][0] * v[r][j][0] + v[r][j][1] * v[r][j][1]) + (v[r][j][2] * v[r][j][2] + v[r][j][3] * v[r][j][3]); }
            rstd[r] = 1.f / sqrtf(wave_sum(s2) * (1.f / D) + LN_EPS); }
#pragma unroll
        for (int r = 0; r < ROWS; ++r)
#pragma unroll
            for (int j = 0; j < 4; ++j) { const f32x4 o = v[r][j] * rstd[r] * gv[j] + bv[j];
                const size_t o_ = (size_t)(base + r) * D + 4 * lane + 256 * j;
                if (xout_f32) { *(f32x4*)(xout_f32 + o_) = o; continue; }
                u32x2 w; w.x = cvt_pk_bf16(o[0], o[1]); w.y = cvt_pk_bf16(o[2], o[3]); *(u32x2*)(xb + o_) = w;
                *(unsigned*)(xr8 + o_) = cvt_pk4_fp8((o[0] - bf_lo(w.x)) * XR_SCALE, (o[1] - bf_hi(w.x)) * XR_SCALE, (o[2] - bf_lo(w.y)) * XR_SCALE, (o[3] - bf_hi(w.y)) * XR_SCALE);
                if (x8) *(unsigned*)(x8 + (size_t)(base + r) * D + 4 * lane + 256 * j) = cvt_pk4_fp8(o[0], o[1], o[2], o[3]); }
    }
}

__device__ __forceinline__ void ya_phase(const Ctx& X, const bf16* Z, const float* conv_a, bf16* Y) {
    const size_t gt = (size_t)X.bid * 512 + X.tid, NT = (size_t)X.G * 512, items = (size_t)T * 64;
    const int cg = (int)(gt & 63), c0 = cg * 8;
    f32x4 w0[3], w1[3];
#pragma unroll
    for (int j = 0; j < 3; ++j) { w0[j] = *(const f32x4*)(conv_a + j * 512 + c0); w1[j] = *(const f32x4*)(conv_a + j * 512 + c0 + 4); }
    for (size_t it = gt; it < items; it += 4 * NT) {
        u32x4 rab[4], rac[4][3], rax[4][3];
#pragma unroll
        for (int u = 0; u < 4; ++u) { const int t = (int)((it + u * NT) >> 6), pos = t & (SEQ - 1);
            rab[u] = *(const u32x4*)(Z + (size_t)t * EV_IN + c0);
#pragma unroll
            for (int j = 0; j < 3; ++j) { const bool ok = pos - 2 + j >= 0; const size_t tt = ok ? (size_t)(t - 2 + j) : (size_t)t;
                rac[u][j] = *(const u32x4*)(Z + tt * EV_IN + 512 + c0); rax[u][j] = *(const u32x4*)(Z + tt * EV_IN + 1024 + c0);
                if (!ok) { rac[u][j] = (u32x4){0u, 0u, 0u, 0u}; } } }
        __builtin_amdgcn_sched_barrier(0);
#pragma unroll
        for (int u = 0; u < 4; ++u) { const int t = (int)((it + u * NT) >> 6); float ab[8], acc[8];
            unpack8(rab[u], ab);
#pragma unroll
            for (int q = 0; q < 8; ++q) acc[q] = 0.f;
#pragma unroll
            for (int j = 0; j < 3; ++j) { float ac[8], ax[8]; unpack8(rac[u][j], ac); unpack8(rax[u][j], ax);
#pragma unroll
                for (int q = 0; q < 4; ++q) { acc[q] += w0[j][q] * (ac[q] * ax[q]); acc[4 + q] += w1[j][q] * (ac[4 + q] * ax[4 + q]); } }
#pragma unroll
            for (int q = 0; q < 8; ++q) acc[q] *= ab[q];
            *(u32x4*)(Y + (size_t)t * EV_Y + c0) = pack8(acc); }
    }
}

__device__ __forceinline__ float gelu_tanh(float x) { const float u = 0.7978845608028654f * (x + 0.044715f * x * x * x); const float e = __expf(2.f * u); const float th = 1.f - 2.f * __builtin_amdgcn_rcpf(e + 1.f); return 0.5f * x * (1.f + th); }
__device__ __forceinline__ void lru_phase(const Ctx& X, const bf16* Z, const bf16* WG  , const float* conv_b, const float* conv_bb, const float* br, const float* bi, const float* k2, bf16* Y) {
    constexpr int RS = 136;
    LAS bf16* WS = (LAS bf16*)X.lds;
    LAS bf16* US = (LAS bf16*)(X.lds + 34816);
    LAS f32x2* AH = (LAS f32x2*)(X.lds + 52224);
    LAS bf16* BG = (LAS bf16*)(X.lds + 84992);
    LAS bf16* YS = (LAS bf16*)(X.lds + 93184);
    LAS f32x2* EX = (LAS f32x2*)(X.lds + 101376);
    const int tid = X.tid, lane = X.lane, w = X.wave, fr = lane & 15, fq = lane >> 4, cg = tid & 15, tb = w & 3, nh = w >> 2;
    for (int unit = X.bid; unit < 256; unit += X.G) {
        const int b = unit >> 4, h = (unit >> 1) & 7, half = unit & 1, hc0 = h * 128, e0 = hc0 + half * 64;
        const size_t row0 = (size_t)b * SEQ;
        __syncthreads();
#pragma unroll
        for (int i = 0; i < 4; ++i) { const int p = tid + 512 * i, n = p >> 4, cp = p & 15; const int srow = (n < 64) ? half * 64 + n : 128 + half * 64 + (n - 64);
            *(LAS u32x4*)(WS + n * RS + cp * 8) = *(const u32x4*)(WG + ((size_t)h * 256 + srow) * 128 + cp * 8); }
        float wcv[4][8], bcv[8];
#pragma unroll
        for (int q = 0; q < 8; ++q) { bcv[q] = conv_bb[hc0 + 8 * cg + q];
#pragma unroll
            for (int j = 0; j < 4; ++j) wcv[j][q] = conv_b[j * 1024 + hc0 + 8 * cg + q]; }
        float brv[2], biv[2], k2v[2];
#pragma unroll
        for (int nbi = 0; nbi < 2; ++nbi) { const int ch = e0 + 16 * (2 * nh + nbi) + fr; brv[nbi] = br[ch]; biv[nbi] = bi[ch]; k2v[nbi] = k2[ch]; }
        float carry = 0.f;
        u32x4 pu[2][4], pg;
#define LRU_LOAD(c) do { _Pragma("unroll") for (int it = 0; it < 2; ++it) { const int t_ = (tid + 512 * it) >> 4; \
                _Pragma("unroll") for (int j = 0; j < 4; ++j) { const int tt = (c) * 64 + t_ - 3 + j; \
                    pu[it][j] = (tt >= 0) ? *(const u32x4*)(Z + (row0 + tt) * EV_IN + 1536 + hc0 + 8 * cg) : (u32x4){0u, 0u, 0u, 0u}; } } \
            pg = *(const u32x4*)(Z + (row0 + (size_t)(c) * 64 + (tid >> 3)) * EV_IN + 2560 + e0 + 8 * (tid & 7)); } while (0)
        LRU_LOAD(0);
        for (int c = 0; c < 64; ++c) {
#pragma unroll
            for (int it = 0; it < 2; ++it) { const int t = (tid + 512 * it) >> 4; float u8[8];
#pragma unroll
                for (int q = 0; q < 8; ++q) u8[q] = bcv[q];
#pragma unroll
                for (int j = 0; j < 4; ++j) { float x8[8]; unpack8(pu[it][j], x8);
#pragma unroll
                    for (int q = 0; q < 8; ++q) u8[q] += wcv[j][q] * x8[q]; }
                *(LAS u32x4*)(US + t * RS + 8 * cg) = pack8(u8); }
            *(LAS u32x4*)(BG + (tid >> 3) * 64 + 8 * (tid & 7)) = pg;
            WG_BAR();
            if (c + 1 < 64) LRU_LOAD(c + 1);
            { bf16x8 af[4];
#pragma unroll
              for (int ks = 0; ks < 4; ++ks) af[ks] = *(const LAS bf16x8*)(US + (16 * tb + fr) * RS + 32 * ks + 8 * fq);
#pragma unroll
              for (int nbi = 0; nbi < 2; ++nbi) { const int nb = 2 * nh + nbi; f32x4 aR = (f32x4){0.f, 0.f, 0.f, 0.f}, aI = (f32x4){0.f, 0.f, 0.f, 0.f};
#pragma unroll
                for (int ks = 0; ks < 4; ++ks) { const bf16x8 wr_ = *(const LAS bf16x8*)(WS + (16 * nb + fr) * RS + 32 * ks + 8 * fq), wi_ = *(const LAS bf16x8*)(WS + (64 + 16 * nb + fr) * RS + 32 * ks + 8 * fq);
                    aR = MFMA16(af[ks], wr_, aR); aI = MFMA16(af[ks], wi_, aI); }
#pragma unroll
                for (int r = 0; r < 4; ++r) { const int t = 16 * tb + 4 * fq + r, ch = 16 * nb + fr;
                    const float rg = fsigmoid(aR[r] + brv[nbi]), ig = fsigmoid(aI[r] + biv[nbi]); const float a = __builtin_amdgcn_exp2f(rg * k2v[nbi]);
                    const float uu = bf1(US[t * RS + half * 64 + ch]);
                    AH[t * 64 + ch] = (f32x2){a, __builtin_sqrtf(fmaxf(1.0f - a * a, 0.f)) * (ig * uu)}; } } }
            WG_BAR();
            { float av[8], xv[8]; float A = 1.f, H = 0.f;
#pragma unroll
              for (int i = 0; i < 8; ++i) { const f32x2 e = AH[(8 * w + i) * 64 + lane]; av[i] = e.x; xv[i] = e.y; H = e.x * H + e.y; A *= e.x; }
              LAS f32x2* ex = EX + (c & 1) * 512;
              ex[w * 64 + lane] = (f32x2){A, H};
              WG_BAR();
              float cc = carry, cin = carry;
#pragma unroll
              for (int ww = 0; ww < 8; ++ww) { const f32x2 e = ex[ww * 64 + lane]; if (ww == w) cin = cc; cc = e.x * cc + e.y; }
              carry = cc;
              float hh = cin;
#pragma unroll
              for (int i = 0; i < 8; ++i) { hh = av[i] * hh + xv[i]; const float gv = bf1(BG[(8 * w + i) * 64 + lane]);
                  YS[(8 * w + i) * 64 + lane] = (bf16)(cvt_pk_bf16(gelu_tanh(gv) * hh, 0.f) & 0xffffu); } }
            WG_BAR();
            *(u32x4*)(Y + (row0 + (size_t)c * 64 + (tid >> 3)) * EV_Y + 512 + e0 + 8 * (tid & 7)) = *(const LAS u32x4*)(YS + (tid >> 3) * 64 + 8 * (tid & 7));
        }
#undef LRU_LOAD
    }
    __syncthreads();
}

__device__ __forceinline__ void gates_phase(const Ctx& X, const bf16* xb, const unsigned char* xr8, const float* w_in  , const float* bg, float* GATES) {
    LAS float* w8 = (LAS float*)X.lds;
    for (int idx = X.tid; idx < 8192; idx += 512) { const int k = idx >> 3, g = idx & 7; w8[g * 1024 + k] = w_in[(size_t)k * OD_IN + OD_INP + g]; }
    __syncthreads();
    const int gw = X.bid * NWAVES + X.wave, NGW = X.G * NWAVES, lane = X.lane;
    const float bgl = bg[lane & 7];
    for (int base = gw * 4; base < T; base += NGW * 4) {
        f32x4 v[4][4];
#pragma unroll
        for (int r = 0; r < 4; ++r)
#pragma unroll
            for (int j = 0; j < 4; ++j) { const size_t o_ = (size_t)(base + r) * D + 4 * lane + 256 * j; const u32x2 w = *(const u32x2*)(xb + o_); const unsigned q8 = *(const unsigned*)(xr8 + o_);
                v[r][j] = (f32x4){bf_lo(w.x), bf_hi(w.x), bf_lo(w.y), bf_hi(w.y)} + (f32x4){__builtin_amdgcn_cvt_f32_fp8(q8, 0), __builtin_amdgcn_cvt_f32_fp8(q8, 1), __builtin_amdgcn_cvt_f32_fp8(q8, 2), __builtin_amdgcn_cvt_f32_fp8(q8, 3)} * XR_INV; }
        float mine[4] = {0.f, 0.f, 0.f, 0.f};
#pragma unroll
        for (int g = 0; g < 8; ++g) { f32x4 wv[4];
#pragma unroll
            for (int j = 0; j < 4; ++j) wv[j] = *(const LAS f32x4*)(w8 + g * 1024 + 4 * lane + 256 * j);
#pragma unroll
            for (int r = 0; r < 4; ++r) { float s = 0.f;
#pragma unroll
                for (int j = 0; j < 4; ++j) s += (v[r][j][0] * wv[j][0] + v[r][j][1] * wv[j][1]) + (v[r][j][2] * wv[j][2] + v[r][j][3] * wv[j][3]);
                s = wave_sum(s); if (lane == g) mine[r] = s; } }
        if (lane < 8) {
#pragma unroll
            for (int r = 0; r < 4; ++r) { float val = mine[r] + bgl;
                if (lane >= 4) val = fminf(val, 0.f) - log1pf(__expf(-fabsf(val)));
                GATES[(size_t)(base + r) * 8 + lane] = val; } }
    }
    __syncthreads();
}

__device__ __forceinline__ void mlstm_phase(const Ctx& X, const bf16* ZO, const float* GATES, bf16* HB) {
    constexpr int RS = 136;
    LAS unsigned char* lds = X.lds;
    LAS bf16* KS = (LAS bf16*)(lds);
    LAS bf16* KT = (LAS bf16*)(lds + 34816);
    LAS bf16* VT = (LAS bf16*)(lds + 69632);
    LAS bf16* CT = (LAS bf16*)(lds + 87040);
    LAS bf16* PS = (LAS bf16*)(lds + 104448) + X.wave * 16 * RS;
    LAS float* SC = (LAS float*)(lds + 139264);
    LAS float *s_a = SC, *s_M = SC + 128, *s_wi = SC + 256, *s_enm = SC + 384, *s_wg = SC + 512, *s_n = SC + 640, *s_misc = SC + 768;
    const int tid = X.tid, lane = X.lane, w = X.wave, fr = lane & 15, fq = lane >> 4;
    for (int unit = X.bid; unit < 256; unit += X.G) {
        const int dvs = unit & 3, bh = unit >> 2, h = bh & 3, b = bh >> 2;
        const size_t row0 = (size_t)b * SEQ;
        const bf16* qbase = ZO + h * 128; const bf16* kbase = ZO + 512 + h * 128; const bf16* vbase = ZO + 1024 + h * 256 + dvs * 64;
        __syncthreads();
        for (int i = tid; i < 64 * RS / 2; i += 512) ((LAS unsigned*)CT)[i] = 0u;
        if (tid < 128) s_n[tid] = 0.f;
        f32x4 accC[4];
#pragma unroll
        for (int i = 0; i < 4; ++i) accC[i] = (f32x4){0.f, 0.f, 0.f, 0.f};
        float nreg = 0.f, m_st = 0.f;
        u32x4 kreg[4], vreg[2]; bf16x8 qn[4]; float gi0 = 0.f, gi1 = 0.f, gf0 = 0.f, gf1 = 0.f;
#define ML_LOAD(c) do { const size_t t0_ = row0 + (size_t)(c) * 128; \
            _Pragma("unroll") for (int i = 0; i < 4; ++i) { const int p = tid + 512 * i; kreg[i] = *(const u32x4*)(kbase + (t0_ + (p & 127)) * OD_INP + (p >> 7) * 8); } \
            _Pragma("unroll") for (int i = 0; i < 2; ++i) { const int p = tid + 512 * i; vreg[i] = *(const u32x4*)(vbase + (t0_ + (p & 127)) * OD_INP + (p >> 7) * 8); } \
            _Pragma("unroll") for (int ks = 0; ks < 4; ++ks) qn[ks] = *(const bf16x8*)(qbase + (t0_ + 16 * w + fr) * OD_INP + 32 * ks + 8 * fq); \
            if (w == 7) { gi0 = GATES[(t0_ + 2 * lane) * 8 + h]; gi1 = GATES[(t0_ + 2 * lane + 1) * 8 + h]; gf0 = GATES[(t0_ + 2 * lane) * 8 + 4 + h]; gf1 = GATES[(t0_ + 2 * lane + 1) * 8 + 4 + h]; } } while (0)
        ML_LOAD(0);
        for (int c = 0; c < 32; ++c) {
            const size_t t0 = row0 + (size_t)c * 128;
#pragma unroll
            for (int i = 0; i < 4; ++i) { const int p = tid + 512 * i, row = p & 127, cp = p >> 7; *(LAS u32x4*)(KS + row * RS + cp * 8) = kreg[i];
                const unsigned ww[4] = {kreg[i].x, kreg[i].y, kreg[i].z, kreg[i].w};
#pragma unroll
                for (int j = 0; j < 4; ++j) { KT[(cp * 8 + 2 * j) * RS + row] = (bf16)(ww[j] & 0xffffu); KT[(cp * 8 + 2 * j + 1) * RS + row] = (bf16)(ww[j] >> 16); } }
#pragma unroll
            for (int i = 0; i < 2; ++i) { const int p = tid + 512 * i, row = p & 127, cp = p >> 7; const unsigned ww[4] = {vreg[i].x, vreg[i].y, vreg[i].z, vreg[i].w};
#pragma unroll
                for (int j = 0; j < 4; ++j) { VT[(cp * 8 + 2 * j) * RS + row] = (bf16)(ww[j] & 0xffffu); VT[(cp * 8 + 2 * j + 1) * RS + row] = (bf16)(ww[j] >> 16); } }
            bf16x8 qc[4];
#pragma unroll
            for (int ks = 0; ks < 4; ++ks) qc[ks] = qn[ks];
            if (w == 7) {
                float sc = gf0 + gf1;
#pragma unroll
                for (int off = 1; off < 64; off <<= 1) { const float t = __shfl_up(sc, off); if (lane >= off) sc += t; }
                const float b1 = sc, b0 = sc - gf1, a0 = gi0 - b0, a1 = gi1 - b1;
                float sm = fmaxf(a0, a1);
#pragma unroll
                for (int off = 1; off < 64; off <<= 1) { const float t = __shfl_up(sm, off); if (lane >= off) sm = fmaxf(sm, t); }
                float prev = __shfl_up(sm, 1); if (lane == 0) prev = -3.0e38f;
                const float M0 = fmaxf(m_st, fmaxf(prev, a0)), M1 = fmaxf(m_st, sm);
                const float Ml = __shfl(M1, 63), bend = __shfl(b1, 63);
                s_a[2 * lane] = a0; s_a[2 * lane + 1] = a1; s_M[2 * lane] = M0; s_M[2 * lane + 1] = M1;
                s_wi[2 * lane] = __expf(m_st - M0); s_wi[2 * lane + 1] = __expf(m_st - M1);
                s_enm[2 * lane] = __expf(-(b0 + M0)); s_enm[2 * lane + 1] = __expf(-(b1 + M1));
                s_wg[2 * lane] = __expf(a0 - Ml); s_wg[2 * lane + 1] = __expf(a1 - Ml);
                if (lane == 0) s_misc[0] = __expf(m_st - Ml);
                m_st = bend + Ml;
            }
            WG_BAR();
            if (c + 1 < 32) ML_LOAD(c + 1);
            const float Mt = s_M[16 * w + fr]; float rs = 0.f;
#pragma unroll
            for (int sb = 0; sb < 8; ++sb) {
                if (sb > w) { *(LAS u32x2*)(PS + fr * RS + 16 * sb + 4 * fq) = (u32x2){0u, 0u}; continue; }
                f32x4 acc = (f32x4){0.f, 0.f, 0.f, 0.f};
#pragma unroll
                for (int ks = 0; ks < 4; ++ks) { const bf16x8 kf = *(const LAS bf16x8*)(KS + (16 * sb + fr) * RS + 32 * ks + 8 * fq); acc = MFMA16(kf, qc[ks], acc); }
                const f32x4 av = *(const LAS f32x4*)(s_a + 16 * sb + 4 * fq); float pv[4];
#pragma unroll
                for (int r = 0; r < 4; ++r) { const int s = 16 * sb + 4 * fq + r, tt = 16 * w + fr; const float e = __expf(av[r] - Mt); const float v = (s <= tt) ? acc[r] * e : 0.f; rs += v; pv[r] = v; }
                *(LAS u32x2*)(PS + fr * RS + 16 * sb + 4 * fq) = (u32x2){cvt_pk_bf16(pv[0], pv[1]), cvt_pk_bf16(pv[2], pv[3])};
            }
            rs += __shfl_xor(rs, 16); rs += __shfl_xor(rs, 32);
            float qn_ = 0.f;
#pragma unroll
            for (int ks = 0; ks < 4; ++ks) { const f32x4 n0 = *(const LAS f32x4*)(s_n + 32 * ks + 8 * fq), n1 = *(const LAS f32x4*)(s_n + 32 * ks + 8 * fq + 4);
                const u32x4 qw = __builtin_bit_cast(u32x4, qc[ks]);
                qn_ += bf_lo(qw.x) * n0[0] + bf_hi(qw.x) * n0[1] + bf_lo(qw.y) * n0[2] + bf_hi(qw.y) * n0[3] + bf_lo(qw.z) * n1[0] + bf_hi(qw.z) * n1[1] + bf_lo(qw.w) * n1[2] + bf_hi(qw.w) * n1[3]; }
            qn_ += __shfl_xor(qn_, 16); qn_ += __shfl_xor(qn_, 32);
            const float wi = s_wi[16 * w + fr], enm = s_enm[16 * w + fr];
            const float den = rs + wi * qn_; const float hden = 1.0f / fmaxf(fabsf(den), enm);
            f32x4 accH[4], accI[4];
#pragma unroll
            for (int i = 0; i < 4; ++i) { accH[i] = (f32x4){0.f, 0.f, 0.f, 0.f}; accI[i] = (f32x4){0.f, 0.f, 0.f, 0.f}; }
#pragma unroll
            for (int ks = 0; ks < 4; ++ks) { if (32 * ks > 16 * w + 15) continue;
                const bf16x8 pf = *(const LAS bf16x8*)(PS + fr * RS + 32 * ks + 8 * fq);
#pragma unroll
                for (int dvb = 0; dvb < 4; ++dvb) { const bf16x8 vf = *(const LAS bf16x8*)(VT + (16 * dvb + fr) * RS + 32 * ks + 8 * fq); accH[dvb] = MFMA16(vf, pf, accH[dvb]); } }
#pragma unroll
            for (int ks = 0; ks < 4; ++ks)
#pragma unroll
                for (int dvb = 0; dvb < 4; ++dvb) { const bf16x8 cf = *(const LAS bf16x8*)(CT + (16 * dvb + fr) * RS + 32 * ks + 8 * fq); accI[dvb] = MFMA16(cf, qc[ks], accI[dvb]); }
#pragma unroll
            for (int dvb = 0; dvb < 4; ++dvb) { float o[4];
#pragma unroll
                for (int r = 0; r < 4; ++r) o[r] = (accH[dvb][r] + wi * accI[dvb][r]) * hden;
                *(u32x2*)(HB + (t0 + 16 * w + fr) * D + h * 256 + dvs * 64 + 16 * dvb + 4 * fq) = (u32x2){cvt_pk_bf16(o[0], o[1]), cvt_pk_bf16(o[2], o[3])}; }
            const float decay = s_misc[0];
#pragma unroll
            for (int i = 0; i < 4; ++i) accC[i] = accC[i] * decay;
            float nadd = 0.f;
#pragma unroll
            for (int ks = 0; ks < 4; ++ks) { const u32x4 kw = *(const LAS u32x4*)(KT + (16 * w + fr) * RS + 32 * ks + 8 * fq);
                const f32x4 g0 = *(const LAS f32x4*)(s_wg + 32 * ks + 8 * fq), g1 = *(const LAS f32x4*)(s_wg + 32 * ks + 8 * fq + 4);
                const float f0 = bf_lo(kw.x) * g0[0], f1 = bf_hi(kw.x) * g0[1], f2 = bf_lo(kw.y) * g0[2], f3 = bf_hi(kw.y) * g0[3], f4 = bf_lo(kw.z) * g1[0], f5 = bf_hi(kw.z) * g1[1], f6 = bf_lo(kw.w) * g1[2], f7 = bf_hi(kw.w) * g1[3];
                nadd += ((f0 + f1) + (f2 + f3)) + ((f4 + f5) + (f6 + f7));
                u32x4 sw; sw.x = cvt_pk_bf16(f0, f1); sw.y = cvt_pk_bf16(f2, f3); sw.z = cvt_pk_bf16(f4, f5); sw.w = cvt_pk_bf16(f6, f7);
                const bf16x8 ktw = __builtin_bit_cast(bf16x8, sw);
#pragma unroll
                for (int dvb = 0; dvb < 4; ++dvb) { const bf16x8 vf = *(const LAS bf16x8*)(VT + (16 * dvb + fr) * RS + 32 * ks + 8 * fq); accC[dvb] = MFMA16(ktw, vf, accC[dvb]); } }
            nadd += __shfl_xor(nadd, 16); nadd += __shfl_xor(nadd, 32);
            nreg = decay * nreg + nadd;
            WG_BAR();
#pragma unroll
            for (int dvb = 0; dvb < 4; ++dvb) *(LAS u32x2*)(CT + (16 * dvb + fr) * RS + 16 * w + 4 * fq) = (u32x2){cvt_pk_bf16(accC[dvb][0], accC[dvb][1]), cvt_pk_bf16(accC[dvb][2], accC[dvb][3])};
            if (fq == 0) s_n[16 * w + fr] = nreg;
        }
#undef ML_LOAD
    }
    __syncthreads();
}

__device__ __forceinline__ void hnorm_phase(const Ctx& X, const bf16* HB, const bf16* ZO, const float* ng, bf16* Y) {
    const int gw = X.bid * NWAVES + X.wave, NGW = X.G * NWAVES, lane = X.lane;
    float gv[16];
#pragma unroll
    for (int j = 0; j < 4; ++j) { const f32x4 t = *(const f32x4*)(ng + 16 * lane + 4 * j); gv[4 * j] = t[0]; gv[4 * j + 1] = t[1]; gv[4 * j + 2] = t[2]; gv[4 * j + 3] = t[3]; }
    for (int base = gw * 4; base < T; base += NGW * 4) {
        u32x4 hw[4][2], ow[4][2];
#pragma unroll
        for (int r = 0; r < 4; ++r)
#pragma unroll
            for (int q = 0; q < 2; ++q) { hw[r][q] = *(const u32x4*)(HB + (size_t)(base + r) * D + 16 * lane + 8 * q); ow[r][q] = *(const u32x4*)(ZO + (size_t)(base + r) * OD_INP + 2048 + 16 * lane + 8 * q); }
#pragma unroll
        for (int r = 0; r < 4; ++r) { float hv[16], ov[16]; { float t8[8]; unpack8(hw[r][0], t8);
#pragma unroll
                for (int q = 0; q < 8; ++q) hv[q] = t8[q]; unpack8(hw[r][1], t8);
#pragma unroll
                for (int q = 0; q < 8; ++q) hv[8 + q] = t8[q]; unpack8(ow[r][0], t8);
#pragma unroll
                for (int q = 0; q < 8; ++q) ov[q] = t8[q]; unpack8(ow[r][1], t8);
#pragma unroll
                for (int q = 0; q < 8; ++q) ov[8 + q] = t8[q]; }
            float ss = 0.f;
#pragma unroll
            for (int q = 0; q < 16; ++q) ss += hv[q] * hv[q];
            ss = row16_sum(ss);
            const float ri = 1.0f / sqrtf(ss * (1.f / 256.f) + RMS_EPS);
            float y0[8], y1[8];
#pragma unroll
            for (int q = 0; q < 8; ++q) { y0[q] = fsigmoid(ov[q]) * (hv[q] * ri * gv[q]); y1[q] = fsigmoid(ov[8 + q]) * (hv[8 + q] * ri * gv[8 + q]); }
            *(u32x4*)(Y + (size_t)(base + r) * D + 16 * lane) = pack8(y0); *(u32x4*)(Y + (size_t)(base + r) * D + 16 * lane + 8) = pack8(y1); }
    }
}

__device__ __forceinline__ void router_phase(const Ctx& X, const bf16* xb, const unsigned char* xr8, const bf16* wrs, const float* brt, int* topi, float* topw, int* cnt) {
    LAS bf16x8* WH = (LAS bf16x8*)X.lds; LAS bf16x8* WLo = (LAS bf16x8*)(X.lds + 65536);
    LAS float* LG = (LAS float*)X.lds + X.wave * (32 * 33);
    LAS int* hist = (LAS int*)(X.lds + 131072);
    const int lane = X.lane, tl = lane & 31, hh = lane >> 5;
    for (int tile = X.bid; tile < T / 256; tile += X.G) {
        __syncthreads();
        for (int i = X.tid; i < 8192; i += 512) ((LAS u32x4*)X.lds)[i] = ((const u32x4*)wrs)[i];
        if (X.tid < 32) hist[X.tid] = 0;
        __syncthreads();
        const int token = tile * 256 + X.wave * 32 + tl;
        const GAS bf16* xr = (const GAS bf16*)(xb + (size_t)token * D + 512 * hh); const GAS unsigned char* xq = (const GAS unsigned char*)(xr8 + (size_t)token * D + 512 * hh);
        f32x16 acc, accr;
#pragma unroll
        for (int r = 0; r < 16; ++r) { acc[r] = 0.f; accr[r] = 0.f; }
        u32x4 xa[6], xc[6];
#define RT_LOAD(xd, o_) do { _Pragma("unroll") for (int q = 0; q < 4; ++q) xd[q] = *(const GAS u32x4*)(xr + (o_) + 8 * q); xd[4] = *(const GAS u32x4*)(xq + (o_)); xd[5] = *(const GAS u32x4*)(xq + (o_) + 16); } while (0)
#define RT_MMA(xd, s0) do { _Pragma("unroll") for (int q = 0; q < 4; ++q) { const bf16x8 af = __builtin_bit_cast(bf16x8, xd[q]); \
            const unsigned r0 = xd[4 + (q >> 1)][(q & 1) * 2], r1 = xd[4 + (q >> 1)][(q & 1) * 2 + 1]; u32x4 rw; \
            rw.x = cvt_pk_bf16(__builtin_amdgcn_cvt_f32_fp8(r0, 0), __builtin_amdgcn_cvt_f32_fp8(r0, 1)); rw.y = cvt_pk_bf16(__builtin_amdgcn_cvt_f32_fp8(r0, 2), __builtin_amdgcn_cvt_f32_fp8(r0, 3)); \
            rw.z = cvt_pk_bf16(__builtin_amdgcn_cvt_f32_fp8(r1, 0), __builtin_amdgcn_cvt_f32_fp8(r1, 1)); rw.w = cvt_pk_bf16(__builtin_amdgcn_cvt_f32_fp8(r1, 2), __builtin_amdgcn_cvt_f32_fp8(r1, 3)); \
            const bf16x8 ar = __builtin_bit_cast(bf16x8, rw); const bf16x8 bh = WH[((s0) + q) * 64 + lane], bl = WLo[((s0) + q) * 64 + lane]; \
            acc = __builtin_amdgcn_mfma_f32_32x32x16_bf16(af, bh, acc, 0, 0, 0); acc = __builtin_amdgcn_mfma_f32_32x32x16_bf16(af, bl, acc, 0, 0, 0); \
            accr = __builtin_amdgcn_mfma_f32_32x32x16_bf16(ar, bh, accr, 0, 0, 0); } } while (0)
        RT_LOAD(xa, 0);
        __builtin_amdgcn_sched_barrier(0);
#pragma unroll 1
        for (int bt = 0; bt < 16; bt += 2) {
            RT_LOAD(xc, 32 * (bt + 1));
            __builtin_amdgcn_sched_barrier(0);
            RT_MMA(xa, 4 * bt);
            __builtin_amdgcn_sched_barrier(0);
            { const int o2 = (bt + 2 < 16) ? 32 * (bt + 2) : 0; RT_LOAD(xa, o2); }
            __builtin_amdgcn_sched_barrier(0);
            RT_MMA(xc, 4 * (bt + 1));
            __builtin_amdgcn_sched_barrier(0);
        }
#undef RT_LOAD
#undef RT_MMA
#pragma unroll
        for (int r = 0; r < 16; ++r) acc[r] += accr[r] * XR_INV;
        __syncthreads();
        const float bias = brt[tl];
#pragma unroll
        for (int r = 0; r < 16; ++r) { const int trow = (r & 3) + 8 * (r >> 2) + 4 * hh; LG[trow * 33 + tl] = acc[r] + bias; }
        LDS_WAIT();
        if (lane < 32) { float v[32];
#pragma unroll
            for (int e = 0; e < 32; ++e) v[e] = LG[lane * 33 + e];
            float tv[4]; int ti[4];
#pragma unroll
            for (int p = 0; p < 4; ++p) { float best = -3.0e38f; int bi = 0;
#pragma unroll
                for (int e = 0; e < 32; ++e) { if (v[e] > best) { best = v[e]; bi = e; } }
#pragma unroll
                for (int e = 0; e < 32; ++e) { if (e == bi) v[e] = -3.0e38f; }
                tv[p] = best; ti[p] = bi; }
            const float e1 = __expf(tv[1] - tv[0]), e2 = __expf(tv[2] - tv[0]), e3 = __expf(tv[3] - tv[0]); const float inv = 1.0f / (1.0f + e1 + e2 + e3);
            const float ws[4] = {inv, e1 * inv, e2 * inv, e3 * inv};
#pragma unroll
            for (int p = 0; p < 4; ++p) { const int rank = __hip_atomic_fetch_add(&hist[ti[p]], 1, __ATOMIC_RELAXED, __HIP_MEMORY_SCOPE_WORKGROUP); topi[(size_t)token * 4 + p] = ti[p] | (rank << 8); topw[(size_t)token * 4 + p] = ws[p]; } }
        __syncthreads();
        if (X.tid < 32) __hip_atomic_store(cnt + tile * 32 + X.tid, hist[X.tid], RLX_AGENT);
        __syncthreads();
    }
}

__device__ __forceinline__ void dispatch_phase(const Ctx& X, const int* cnt, const int* topi, int* posmap, int* tile_e  , int* rowtok  , unsigned char* zrow  ) {
    LAS int* s_tot = (LAS int*)X.lds; LAS int* s_seg = s_tot + 32; LAS int* s_mine = s_tot + 96; LAS int* s_pos = s_tot + 128;
    const int tid = X.tid, lane = X.lane;
    LAS int* s_cnt = (LAS int*)(X.lds + 16384);
    __syncthreads();
    for (int i = tid; i < 8192; i += 512) s_cnt[i] = __hip_atomic_load(cnt + i, RLX_AGENT);
    __syncthreads();
    if (tid < 32) { int tot = 0; for (int wg = 0; wg < 256; ++wg) tot += s_cnt[wg * 32 + tid]; s_tot[tid] = tot; }
    __syncthreads();
    if (tid == 0) { int seg = 0; for (int e = 0; e < 32; ++e) { s_seg[e] = seg; seg += (s_tot[e] + 255) & ~255; } s_seg[32] = seg; }
    __syncthreads();
    if (X.bid == 0) { const int nmt = s_seg[32] >> 8;
        for (int mt = tid; mt < nmt; mt += 512) { int e = 0; for (int q = 0; q < 32; ++q) if (s_seg[q] <= mt * 256) e = q; __hip_atomic_store(tile_e + mt, e, RLX_AGENT); }
        if (tid == 0) __hip_atomic_store(tile_e + MAXMT, nmt, RLX_AGENT); }
    if (X.bid == X.G - 1 && tid < 64) *(u32x4*)(zrow + 16 * tid) = (u32x4){0u, 0u, 0u, 0u};
    for (int e = X.bid; e < 32; e += X.G) {
        const int r0 = s_seg[e] + s_tot[e], r1 = s_seg[e + 1];
        for (int i = r0 + tid; i < r1; i += 512) rowtok[i] = T; }
    for (int tile = X.bid; tile < T / 256; tile += X.G) {
        __syncthreads();
        if (tid < 32) { int mine = 0; for (int wg = 0; wg < tile; ++wg) mine += s_cnt[wg * 32 + tid]; s_mine[tid] = mine; }
        __syncthreads();
        for (int idx = tid; idx < 1024; idx += 512) { const int pk = topi[(size_t)tile * 1024 + idx], e = pk & 255, rank = pk >> 8; const int pos = s_seg[e] + s_mine[e] + rank; posmap[(size_t)tile * 1024 + idx] = pos; rowtok[pos] = tile * 256 + (idx >> 2); }
    }
    __syncthreads();
}

struct Args { const float* in[28]; float* out; unsigned char* ws; int lo, hi; };
enum { I_X = 0, I_MEM, I_EV_WIN, I_EV_CA, I_EV_CB, I_EV_CBB, I_EV_WR, I_EV_BR, I_EV_WI, I_EV_BI, I_EV_LAM, I_EV_WOUT, I_OD_WIN, I_OD_BG, I_OD_NG, I_OD_WOUT,
       I_WQ, I_WK, I_WV, I_WO, I_WRT, I_BRT, I_W1, I_B1, I_W2, I_B2, I_LNG, I_LNB };

template <int IDX> __device__ __forceinline__ const float* karg() {
    auto ka = __builtin_amdgcn_kernarg_segment_ptr();
    unsigned long long v; asm volatile("s_load_dwordx2 %0, %1, %2\n\ts_waitcnt lgkmcnt(0)" : "=s"(v) : "s"(ka), "n"(IDX * 8)); return (const float*)v; }
#define KIN(i) karg<i>()

#ifndef PH_MASK
#define PH_MASK 0xffffffffu
#endif
#ifndef REP_MASK
#define REP_MASK 0u
#endif
#define PH_BEGIN(g, kind) if (((PH_MASK >> (kind)) & 1u) && lo <= (g) && (g) < hi) { for (int rep_ = 0; rep_ <= (int)((REP_MASK >> (kind)) & 1u); ++rep_) { Ctx X = X0; X.lane = lane_id_opaque(); X.tid = X.wave * 64 + X.lane; unsigned char* ws = ws0; asm volatile("" : "+s"(ws));
#define PH_END(g) } if ((g) + 1 < hi) xcd_barrier(bar); }

#define XB ((bf16*)(ws + WS_XB))
#define MIX ((bf16*)(ws + WS_MIX))
#define MEMB ((bf16*)(ws + WS_MEMB))
#define KM ((bf16*)(ws + WS_KM))
#define VTm ((bf16*)(ws + WS_VT))
#define XF (out_f32)
#define K2 ((float*)(ws + WS_K2))


template <int LAYER>
__device__ __forceinline__ void layer_body(const Ctx& X0, unsigned char* ws0, float* out_f32, const XcdBarrier& bar, const int lo, const int hi) {
    constexpr int layer = LAYER;
    unsigned char* ws = ws0;
        const int gb = 3 + layer * 16, jl = layer >> 1;
        if ((layer & 1) == 0) {
            bf16* Z = (bf16*)(ws + R_Z); bf16* Y = (bf16*)(ws + WS_Y);
            PH_BEGIN(gb + 0, 2)
                pg8::Gemm g{1024, 1024, 1024};
                pg8::DenseOrder S{(const char*)XB, (const char*)(ws + W_EVIN) + (size_t)jl * EV_IN * 1024 * 2, (size_t)256 * 1024 * 2, (size_t)256 * 1024 * 2, 256, EV_IN / 256, X.G, X.bid};
                pg8::EpiStore E{Z, EV_IN, 0, nullptr, 0, 1.0f, 0};
                pg8::gemm_phase(X.lds, g, S, E, X.wave);
            PH_END(gb + 0)
            PH_BEGIN(gb + 1, 3)
                ya_phase(X, Z, KIN(I_EV_CA) + (size_t)jl * 3 * 512, Y);
                lru_phase(X, Z, (const bf16*)(ws + W_GATE) + (size_t)jl * 8 * 256 * 128, KIN(I_EV_CB) + (size_t)jl * 4 * 1024, KIN(I_EV_CBB) + (size_t)jl * 1024,
                          KIN(I_EV_BR) + (size_t)jl * 1024, KIN(I_EV_BI) + (size_t)jl * 1024, K2 + (size_t)jl * 1024, Y);
            PH_END(gb + 1)
            PH_BEGIN(gb + 4, 6)
                pg8::Gemm g{EV_Y, EV_Y, EV_Y};
                pg8::DenseOrder S{(const char*)Y, (const char*)(ws + W_EVOUT) + (size_t)jl * 1024 * EV_Y * 2, (size_t)256 * EV_Y * 2, (size_t)256 * EV_Y * 2, 256, 4, X.G, X.bid};
                pg8::EpiStore E{MIX, 1024, 0, nullptr, 0, 1.0f, 0};
                pg8::gemm_phase(X.lds, g, S, E, X.wave);
            PH_END(gb + 4)
        } else {
            bf16* ZO = (bf16*)(ws + R_Z); bf16* HB = (bf16*)(ws + R_HB); bf16* Y = (bf16*)(ws + WS_Y); float* GATES = (float*)(ws + WS_GATES);
            PH_BEGIN(gb + 0, 7)
                gates_phase(X, XB, ws + WS_XR8, KIN(I_OD_WIN) + (size_t)jl * 1024 * OD_IN, KIN(I_OD_BG) + (size_t)jl * 8, GATES);
                pg8::Gemm g{1024, 1024, 1024};
                pg8::DenseOrder S{(const char*)XB, (const char*)(ws + W_ODIN) + (size_t)jl * OD_INP * 1024 * 2, (size_t)256 * 1024 * 2, (size_t)256 * 1024 * 2, 256, OD_INP / 256, X.G, X.bid};
                pg8::EpiStore E{ZO, OD_INP, 0, nullptr, 0, 0.08838834764831845f, 2};
                pg8::gemm_phase(X.lds, g, S, E, X.wave);
            PH_END(gb + 0)
            PH_BEGIN(gb + 1, 8)
                mlstm_phase(X, ZO, GATES, HB);
            PH_END(gb + 1)
            PH_BEGIN(gb + 2, 9)
                hnorm_phase(X, HB, ZO, KIN(I_OD_NG) + (size_t)jl * 1024, Y);
            PH_END(gb + 2)
            PH_BEGIN(gb + 4, 10)
                pg8::Gemm g{1024, 1024, 1024};
                pg8::DenseOrder S{(const char*)Y, (const char*)(ws + W_ODOUT) + (size_t)jl * 1024 * 1024 * 2, (size_t)256 * 1024 * 2, (size_t)256 * 1024 * 2, 256, 4, X.G, X.bid};
                pg8::EpiStore E{MIX, 1024, 0, nullptr, 0, 1.0f, 0};
                pg8::gemm_phase(X.lds, g, S, E, X.wave);
            PH_END(gb + 4)
        }
        PH_BEGIN(gb + 5, 11)
            ln_phase<false, 4>(X, layer == 0 ? KIN(I_X) : nullptr, MIX, nullptr, nullptr, KIN(I_LNG) + (size_t)layer * 3 * D, KIN(I_LNB) + (size_t)layer * 3 * D, nullptr, XB, ws + WS_XR8, ws + R_XA8);
        PH_END(gb + 5)
        {
            bf16* Q = (bf16*)(ws + R_Q); bf16* P = (bf16*)(ws + R_P); bf16* O = (bf16*)(ws + R_O);
            PH_BEGIN(gb + 6, 12)
                pg8::Gemm g{512, 512, 512};
                pg8::BatchOrder S{(const char*)(ws + R_XA8), (const char*)(ws + WS_M1) + (size_t)layer * 16 * 1024 * 1024, (size_t)256 * 1024, (size_t)0, (size_t)1024 * 1024, (size_t)256 * 1024, 4, 256, 4, X.G, X.bid};
                pg8::EpiSoftmax E{(unsigned char*)P, 0.0625f / M1_SCALE};
                pg8::gemm_phase<pg8::EpiSoftmax, pg8::BatchOrder, true>(X.lds, g, S, E, X.wave);
            PH_END(gb + 6)
            PH_BEGIN(gb + 9, 15)
                pg8::Gemm g{512, 512, 512};
                pg8::BatchOrder S{(const char*)P, (const char*)(ws + WS_M2) + (size_t)layer * 16 * 1024 * 1024, (size_t)256 * 1024, (size_t)0, (size_t)1024 * 1024, (size_t)256 * 1024, 4, 256, 4, X.G, X.bid};
                pg8::EpiStore E{MIX, 1024, 0, nullptr, 0, 1.0f, 0, 1.0f / (256.0f * M2_SCALE)};
                pg8::gemm_phase<pg8::EpiStore, pg8::BatchOrder, true>(X.lds, g, S, E, X.wave);
            PH_END(gb + 9)
        }
        PH_BEGIN(gb + 10, 16)
            ln_phase<false, 4>(X, nullptr, MIX, nullptr, nullptr, KIN(I_LNG) + (size_t)layer * 3 * D + D, KIN(I_LNB) + (size_t)layer * 3 * D + D, nullptr, XB, ws + WS_XR8, ws + R_XG);
        PH_END(gb + 10)
        {
            int* topi = (int*)(ws + WS_TOPI); float* topw = (float*)(ws + WS_TOPW); int* posmap = (int*)(ws + WS_POSMAP);
            int* cnt = (int*)(ws + WS_CNT) + (size_t)layer * 8192; int* tile_e = (int*)(ws + WS_TILEE) + (size_t)layer * 2048;
            unsigned char* XG = ws + R_XG; unsigned char* HID = ws + R_HID; bf16* EO = (bf16*)(ws + R_EO);
            PH_BEGIN(gb + 11, 17)
                router_phase(X, XB, ws + WS_XR8, (const bf16*)(ws + WS_WRT) + (size_t)layer * 65536, KIN(I_BRT) + (size_t)layer * 32, topi, topw, cnt);
            PH_END(gb + 11)
            PH_BEGIN(gb + 12, 18)
                dispatch_phase(X, cnt, topi, posmap, tile_e, (int*)(ws + WS_ROWTOK), XG + (size_t)T * D);
            PH_END(gb + 12)
            PH_BEGIN(gb + 13, 19)
                const int nmt = __builtin_amdgcn_readfirstlane(__hip_atomic_load(tile_e + MAXMT, RLX_AGENT));
                pg8::Gemm g{512, 512, 512, (const int*)(ws + WS_ROWTOK)};
                LAS int* te = (LAS int*)(X.lds + XCH_OFF); for (int i = X.tid; i < nmt; i += 512) te[i] = __hip_atomic_load(tile_e + i, RLX_AGENT); __syncthreads();
                pg8::MoeOrder S{(const char*)XG, (const char*)(ws + W_1) + (size_t)layer * 32 * 2048 * 1024, (size_t)0, (size_t)2048 * 1024, (size_t)256 * 1024, te, nmt, 8, X.G, X.bid};
                pg8::EpiSwiglu E{HID, KIN(I_B1) + (size_t)layer * 32 * 2048, 1.0f / W1_SCALE};
                pg8::gemm_phase<pg8::EpiSwiglu, pg8::MoeOrder, true, true>(X.lds, g, S, E, X.wave);
            PH_END(gb + 13)
            PH_BEGIN(gb + 14, 20)
                const int nmt = __builtin_amdgcn_readfirstlane(__hip_atomic_load(tile_e + MAXMT, RLX_AGENT));
                pg8::Gemm g{512, 512, 512};
                LAS int* te = (LAS int*)(X.lds + XCH_OFF); for (int i = X.tid; i < nmt; i += 512) te[i] = __hip_atomic_load(tile_e + i, RLX_AGENT); __syncthreads();
                pg8::MoeOrder S{(const char*)HID, (const char*)(ws + W_2) + (size_t)layer * 32 * 1024 * 1024, (size_t)256 * 1024, (size_t)1024 * 1024, (size_t)256 * 1024, te, nmt, 4, X.G, X.bid};
                pg8::EpiStore8T<true> E{(unsigned char*)EO, 1024, EO_SCALE, KIN(I_B2) + (size_t)layer * 32 * 1024, 1024, 1.0f / W2_SCALE};
                pg8::gemm_phase<pg8::EpiStore8T<true>, pg8::MoeOrder, true>(X.lds, g, S, E, X.wave);
            PH_END(gb + 14)
            PH_BEGIN(gb + 15, 21)
                ln_phase<true, 2>(X, nullptr, EO, posmap, topw, KIN(I_LNG) + (size_t)layer * 3 * D + 2 * D, KIN(I_LNB) + (size_t)layer * 3 * D + 2 * D, layer == DEPTH - 1 ? XF : nullptr, XB, ws + WS_XR8);
            PH_END(gb + 15)
        }
    }

__global__ void __launch_bounds__(512, 2) mk_fwd(Args args) {
    extern __shared__ __attribute__((aligned(16))) unsigned char lds_raw[];
    Ctx X0; X0.lds = (LAS unsigned char*)lds_raw; X0.tid = threadIdx.x; X0.lane = X0.tid & 63; X0.wave = __builtin_amdgcn_readfirstlane(X0.tid >> 6);     X0.bid = blockIdx.x; X0.G = gridDim.x;
    unsigned char* ws0 = args.ws;
    unsigned char* ws = ws0;
    volatile LAS unsigned* MISC = (volatile LAS unsigned*)(X0.lds + MISC_OFF);
    if (X0.tid < 64) MISC[X0.tid] = 0u;
    __syncthreads();
    XcdBarrier bar; bar.bar = (unsigned*)(ws + WS_CTL) + CW_BAR; bar.x = 0; bar.st = MISC; bar.wave = X0.wave;
    if (args.hi - args.lo > 1) bar = xcd_barrier_post((unsigned*)(ws + WS_CTL) + CW_BAR, MISC, X0.wave);
    const int lo = args.lo, hi = args.hi;
    PH_BEGIN(0, 0)
        conv_group(X, KIN(I_EV_WIN), 2, 1024, EV_IN, EV_IN, (size_t)1024 * EV_IN, (bf16*)(ws + W_EVIN), (size_t)EV_IN * 1024, 0);
        conv_group(X, KIN(I_EV_WOUT), 2, EV_Y, 1024, 1024, (size_t)EV_Y * 1024, (bf16*)(ws + W_EVOUT), (size_t)1024 * EV_Y, 0);
        conv_group(X, KIN(I_EV_WR), 16, 128, 128, 128, (size_t)128 * 128, (bf16*)(ws + W_GATE), (size_t)256 * 128, 0);
        conv_group(X, KIN(I_EV_WI), 16, 128, 128, 128, (size_t)128 * 128, (bf16*)(ws + W_GATE) + 128 * 128, (size_t)256 * 128, 0);
        conv_group(X, KIN(I_OD_WIN), 2, 1024, OD_INP, OD_IN, (size_t)1024 * OD_IN, (bf16*)(ws + W_ODIN), (size_t)OD_INP * 1024, 0);
        conv_group(X, KIN(I_OD_WOUT), 2, 1024, 1024, 1024, (size_t)1024 * 1024, (bf16*)(ws + W_ODOUT), (size_t)1024 * 1024, 0);
        cvt_flat8(X, KIN(I_WQ), ws + W_Q, (size_t)4 * 1024 * 1024, WQ_SCALE);
        conv_group(X, KIN(I_WK), 4, 1024, 1024, 1024, (size_t)1024 * 1024, (bf16*)(ws + W_K), (size_t)1024 * 1024, 0, WQ_SCALE);
        conv_group(X, KIN(I_WV), 4, 1024, 1024, 1024, (size_t)1024 * 1024, (bf16*)(ws + W_V), (size_t)1024 * 1024, 0, WQ_SCALE);
        conv_group(X, KIN(I_WO), 4, 1024, 1024, 1024, (size_t)1024 * 1024, (bf16*)(ws + W_O), (size_t)1024 * 1024, 0, WO_SCALE);
        conv_group(X, KIN(I_W1), 128, 1024, 2048, 2048, (size_t)1024 * 2048, (bf16*)(ws + W_1), (size_t)2048 * 1024, 1, W1_SCALE);
        conv_group(X, KIN(I_W2), 128, 1024, 1024, 1024, (size_t)1024 * 1024, (bf16*)(ws + W_2), (size_t)1024 * 1024, 0, W2_SCALE);
        cvt_flat(X, KIN(I_X), XB, (size_t)T * D);
        cvt_flat8(X, KIN(I_MEM), (unsigned char*)MEMB, (size_t)NBATCH * NMEM * D);
        for (int i = X.bid * 512 + X.tid; i < 4 * 32768; i += X.G * 512) {
            const int l = i >> 15, s_ = (i >> 9) & 63, ln = (i >> 3) & 63, j = i & 7; const int k = 512 * (ln >> 5) + 8 * s_ + j, e = ln & 31;
            const float wv = KIN(I_WRT)[(size_t)l * 32768 + k * 32 + e]; const unsigned hi = cvt_pk_bf16(wv, 0.f) & 0xffffu; const float lo = wv - __uint_as_float(hi << 16);
            bf16* dst = (bf16*)(ws + WS_WRT) + (size_t)l * 65536; dst[(i & 32767)] = (bf16)hi; dst[32768 + (i & 32767)] = (bf16)(cvt_pk_bf16(lo, 0.f) & 0xffffu); }
        for (int i = X.bid * 512 + X.tid; i < 2048; i += X.G * 512) { const float lam = KIN(I_EV_LAM)[i]; const float sp = fmaxf(-lam, 0.f) + log1pf(__expf(-fabsf(lam)));
            K2[i] = -8.0f * sp * 1.4426950408889634f; }
        __syncthreads();
    PH_END(0)

    PH_BEGIN(1, 1)
        { pg8::Gemm g{512, 512, 512};
          pg8::StackOrder S{(const char*)MEMB, (const char*)(ws + W_K), (size_t)256 * 1024, (size_t)256 * 1024, 0, (size_t)1024 * 1024, 16, 4, 4, X.G, X.bid};
          pg8::EpiStore8 E{(unsigned char*)KM, 1024, 1.0f / WQ_SCALE, nullptr, 0, 1.0f, (size_t)4096 * 1024};
          pg8::gemm_phase<pg8::EpiStore8, pg8::StackOrder, true>(X.lds, g, S, E, X.wave); }
        { pg8::Gemm g{512, 512, 512};
          pg8::StackOrder S{(const char*)MEMB, (const char*)(ws + W_V), (size_t)256 * 1024, (size_t)256 * 1024, 0, (size_t)1024 * 1024, 16, 4, 4, X.G, X.bid};
          pg8::EpiStore8 E{(unsigned char*)VTm, 1024, 1.0f / WQ_SCALE, nullptr, 0, 1.0f, (size_t)4096 * 1024};
          pg8::gemm_phase<pg8::EpiStore8, pg8::StackOrder, true>(X.lds, g, S, E, X.wave); }
    PH_END(1)

    PH_BEGIN(2, 22)
        { pg8::Gemm g{512, 512, 128};
          pg8::FoldOrder S{(const char*)KM, (const char*)(ws + W_Q), false, X.G, X.bid};
          pg8::EpiStore8 E{ws + WS_M1, 1024, M1_SCALE / WQ_SCALE, nullptr, 0, 1.0f, (size_t)256 * 1024};
          pg8::gemm_phase<pg8::EpiStore8, pg8::FoldOrder, true>(X.lds, g, S, E, X.wave); }
        { pg8::Gemm g{512, 512, 128};
          pg8::FoldOrder S{(const char*)(ws + W_O), (const char*)VTm, true, X.G, X.bid};
          pg8::EpiStore8 E{ws + WS_M2, 1024, M2_SCALE / WO_SCALE, nullptr, 0, 1.0f, (size_t)1024 * 1024};
          pg8::gemm_phase<pg8::EpiStore8, pg8::FoldOrder, true>(X.lds, g, S, E, X.wave); }
    PH_END(2)

    layer_body<0>(X0, ws0, args.out, bar, lo, hi); layer_body<1>(X0, ws0, args.out, bar, lo, hi); layer_body<2>(X0, ws0, args.out, bar, lo, hi); layer_body<3>(X0, ws0, args.out, bar, lo, hi);
#undef PH_BEGIN
#undef PH_END
}

extern "C" void kernel_launch(void* const* d_in, const int* in_sizes, int n_in, void* d_out, int out_size, void* d_ws, size_t ws_size, hipStream_t stream) {
    static int grid = 0;
    if (grid == 0) {
        if (n_in != 28 || in_sizes[0] != T * D || out_size != T * D || ws_size < WS_END) { fprintf(stderr, "kernel_launch: unexpected shapes (n_in %d, in0 %d, out %d, ws %zu, need %zu); nothing launched\n", n_in, n_in > 0 ? in_sizes[0] : -1, out_size, ws_size, (size_t)WS_END); grid = -1; return; }
        int dev = 0, cus = 0, per_cu = 0;
        if (hipGetDevice(&dev) != hipSuccess || hipDeviceGetAttribute(&cus, hipDeviceAttributeMultiprocessorCount, dev) != hipSuccess) { grid = -1; return; }
        if (hipFuncSetAttribute((const void*)mk_fwd, hipFuncAttributeMaxDynamicSharedMemorySize, LDS_BYTES) != hipSuccess) { fprintf(stderr, "kernel_launch: hipFuncSetAttribute failed\n"); grid = -1; return; }
        if (hipOccupancyMaxActiveBlocksPerMultiprocessor(&per_cu, (const void*)mk_fwd, 512, LDS_BYTES) != hipSuccess || per_cu < 1) { fprintf(stderr, "kernel_launch: occupancy query reports %d\n", per_cu); }
        (void)hipGetLastError();
        grid = cus;
    }
    if (grid < 0) return;
    if (hipMemsetAsync((char*)d_ws + WS_CTL, 0, CTL_ZERO_BYTES, stream) != hipSuccess) return;
    Args a{};
    for (int i = 0; i < 28; ++i) a.in[i] = (const float*)d_in[i];
    a.out = (float*)d_out; a.ws = (unsigned char*)d_ws;
#if MK_N_LAUNCHES == 1
    a.lo = 0; a.hi = 3 + DEPTH * 16;
    hipLaunchKernelGGL(mk_fwd, dim3(grid), dim3(512), LDS_BYTES, stream, a);
#else
    for (int g = 0; g < 3 + DEPTH * 16; ++g) {
        if (g >= 3) { const int layer = (g - 3) / 16, k = (g - 3) % 16; if (k == 7 || k == 8) continue; if ((layer & 1) && k == 3) continue; if (!(layer & 1) && (k == 2 || k == 3)) continue; }
        a.lo = g; a.hi = g + 1;
        hipLaunchKernelGGL(mk_fwd, dim3(grid), dim3(512), LDS_BYTES, stream, a);
    }
#endif
}
```

```cpp
#include <hip/hip_runtime.h>
#include <cstdio>
#include <cstdint>

#ifndef MK_N_LAUNCHES
#define MK_N_LAUNCHES 1
#endif

#define GAS __attribute__((address_space(1)))
#define LAS __attribute__((address_space(3)))
typedef unsigned short bf16;
typedef short bf16x8 __attribute__((ext_vector_type(8)));
typedef short bf16x4 __attribute__((ext_vector_type(4)));
typedef float f32x2 __attribute__((ext_vector_type(2)));
typedef float f32x4 __attribute__((ext_vector_type(4)));
typedef float f32x16 __attribute__((ext_vector_type(16)));
typedef unsigned u32x2 __attribute__((ext_vector_type(2)));
typedef unsigned u32x4 __attribute__((ext_vector_type(4)));
typedef int i32x4 __attribute__((ext_vector_type(4)));
typedef int i32x8 __attribute__((ext_vector_type(8)));
typedef GAS unsigned gu32;
#define RLX_AGENT __ATOMIC_RELAXED, __HIP_MEMORY_SCOPE_AGENT
#define LDS_WAIT() asm volatile("s_waitcnt lgkmcnt(0)" ::: "memory")
#define VM_WAIT() asm volatile("s_waitcnt vmcnt(0)" ::: "memory")
#define WG_BAR() do { asm volatile("s_waitcnt lgkmcnt(0)" ::: "memory"); __builtin_amdgcn_s_barrier(); asm volatile("" ::: "memory"); } while (0)

constexpr int T = 65536, D = 1024, SEQ = 4096, NBATCH = 16, NMEM = 256, DEPTH = 4;
constexpr int EV_IN = 3584, OD_IN = 3080, OD_INP = 3072, EV_Y = 1536;
constexpr int NEXP = 32, DFF = 1024;
constexpr float DN_ALPHA = 1.6817928305074290f;
constexpr float LN_EPS = 1e-5f, RMS_EPS = 1e-6f;
constexpr float XR_SCALE = 4096.0f, XR_INV = 1.0f / 4096.0f;
constexpr float W1_SCALE = 64.0f, W2_SCALE = 128.0f, WQ_SCALE = 64.0f, WO_SCALE = 128.0f, O8_SCALE = 8.0f, EO_SCALE = 4.0f, M1_SCALE = 2.0f, M2_SCALE = 4.0f;
constexpr int MAXMT = 1056;

__device__ __forceinline__ unsigned cvt_pk_bf16(float lo, float hi) { unsigned r; asm("v_cvt_pk_bf16_f32 %0, %1, %2" : "=v"(r) : "v"(lo), "v"(hi)); return r; }
__device__ __forceinline__ unsigned cvt_pk4_fp8(float a, float b, float c, float d) { int p = __builtin_amdgcn_cvt_pk_fp8_f32(a, b, 0, false); p = __builtin_amdgcn_cvt_pk_fp8_f32(c, d, p, true); return (unsigned)p; }
__device__ __forceinline__ float bf_lo(unsigned w) { return __uint_as_float(w << 16); }
__device__ __forceinline__ float bf_hi(unsigned w) { return __uint_as_float(w & 0xffff0000u); }
__device__ __forceinline__ float bf1(bf16 v) { return __uint_as_float(((unsigned)v) << 16); }
__device__ __forceinline__ float fsigmoid(float x) { return __builtin_amdgcn_rcpf(1.0f + __expf(-x)); }
#define DPP_F(v, ctrl) __builtin_bit_cast(float, __builtin_amdgcn_update_dpp(0, __builtin_bit_cast(int, (v)), (ctrl), 0xf, 0xf, true))
__device__ __forceinline__ float row16_sum(float v) { v += DPP_F(v, 0xB1); v += DPP_F(v, 0x4E); v += DPP_F(v, 0x141); v += DPP_F(v, 0x140); return v; }
__device__ __forceinline__ float rdlane(float v, int l) { return __builtin_bit_cast(float, __builtin_amdgcn_readlane(__builtin_bit_cast(int, v), l)); }
__device__ __forceinline__ float wave_sum(float v) { v = row16_sum(v); return (rdlane(v, 0) + rdlane(v, 16)) + (rdlane(v, 32) + rdlane(v, 48)); }

__device__ __forceinline__ int lane_id_opaque() { int l; asm volatile("v_mbcnt_lo_u32_b32 %0, -1, 0\n\tv_mbcnt_hi_u32_b32 %0, -1, %0" : "=v"(l)); return l; }
namespace pg8 {
constexpr int BM = 256, BK = 64, HALF = 128, HTB = HALF * BK * 2, STAGE_BYTES = 8 * HTB, NXCD = 8, WGM = 8;
__host__ __device__ __forceinline__ int lds_byte(int r, int c) { const int st = (r >> 4) * 2 + (c >> 5), rr = r & 15, cc = c & 31, ob = rr * 64 + cc * 2; return st * 1024 + (ob ^ (((ob >> 9) & 1) << 5)); }
__host__ __device__ __forceinline__ void stage_rc(int b, int& R, int& C) { const int st = b / 1024, sb = b % 1024, swz = sb ^ (((sb >> 9) & 1) << 5); R = (st >> 1) * 16 + swz / 64; C = (st & 1) * 32 + (swz % 64) / 2; }
__host__ __device__ __forceinline__ int perm32(int rho) { const int n = rho >> 4, i = rho & 15; return 8 * (i >> 2) + 4 * n + (i & 3); }

struct Unit { const char* a; const char* b; int pm, pn, z; };
struct Gemm { int lda, ldb, K; const int* gidx = nullptr; };

__device__ __forceinline__ bool static_map(long L, int nM, int nN, int& pm, int& pn) {
    const int nwg = nM * nN; if (L >= nwg) return false;
    int wgid = (int)L; { const int q = nwg / NXCD, r = nwg % NXCD, xcd = wgid % NXCD, off = wgid / NXCD; wgid = (xcd < r ? xcd * (q + 1) : r * (q + 1) + (xcd - r) * q) + off; }
    const int nig = WGM * nN, gid = wgid / nig, fm = gid * WGM, gsz = (nM - fm) < WGM ? (nM - fm) : WGM;
    pm = fm + ((wgid % nig) % gsz); pn = (wgid % nig) / gsz; return true;
}

template <class Epi, class Sched, bool F8 = false, bool GA = false>
__device__ __forceinline__ void gemm_phase(LAS unsigned char* lds, const Gemm g, const Sched& S, const Epi& E, int wave) {
    const int lane = lane_id_opaque(), wid = wave, tid = wid * 64 + lane,
              wr = wid >> 2, wc = wid & 3, fr = lane & 15, fq = lane >> 4;
    int K_ = g.K; asm volatile("" : "+s"(K_));
    const int K = K_, nt = K / BK;
    unsigned voffA[2], voffB[2]; int RA[2]; unsigned CB[2];
#pragma unroll
    for (int i = 0; i < 2; ++i) { int R, C; stage_rc(tid * 16 + i * 8192, R, C); const int Rb = Epi::PERM ? ((R & ~31) + perm32(R & 31)) : R;
        voffA[i] = (unsigned)(R * g.lda + C) * 2u; voffB[i] = (unsigned)(Rb * g.ldb + C) * 2u; RA[i] = R; CB[i] = (unsigned)C * 2u; }
    const unsigned rowb = (unsigned)g.lda * 2u;
    unsigned vG[2][2], vGN[2][2];
    LAS unsigned char* const gslot = lds + STAGE_BYTES + 8192;
    const size_t kstep = (size_t)(BK * 2);
    const size_t hstepA = (size_t)HALF * g.lda * 2, hstepB = (size_t)HALF * g.ldb * 2;
    const unsigned ldsw = (unsigned)wid * 1024u;
    const int aoff = lds_byte(wr * 64 + fr, fq * 8), boff = lds_byte(wc * 32 + fr, fq * 8);
#define PG8_SA(b, h) (((b) * 2 + (h)) * HTB)
#define PG8_SB(b, h) ((4 + (b) * 2 + (h)) * HTB)
#define PG8_STAGE(bufoff, gbase, voff) do { _Pragma("unroll") for (int _i = 0; _i < 2; ++_i) \
        __builtin_amdgcn_global_load_lds((const unsigned*)((const char*)(gbase) + (voff)[_i]), (LAS unsigned*)(lds + (bufoff) + ldsw + _i * 8192), 16, 0, 0); } while (0)
#define PG8_LDA(dst, b, h) do { _Pragma("unroll") for (int m = 0; m < 4; ++m) _Pragma("unroll") for (int k = 0; k < 2; ++k) dst[m][k] = *(const LAS bf16x8*)(lds + PG8_SA(b, h) + aoff + m * 2048 + k * 1024); } while (0)
#define PG8_LDB(dst, b, h) do { _Pragma("unroll") for (int n = 0; n < 2; ++n) _Pragma("unroll") for (int k = 0; k < 2; ++k) dst[n][k] = *(const LAS bf16x8*)(lds + PG8_SB(b, h) + boff + n * 2048 + k * 1024); } while (0)
#define PG8_CAT(x) __builtin_shufflevector(__builtin_bit_cast(i32x4, (x)[0]), __builtin_bit_cast(i32x4, (x)[1]), 0, 1, 2, 3, 4, 5, 6, 7)
#define PG8_MMA(ai, bj, At, Bt) do { __builtin_amdgcn_s_setprio(1); \
        if constexpr (F8) { _Pragma("unroll") for (int m = 0; m < 4; ++m) _Pragma("unroll") for (int n = 0; n < 2; ++n) \
            asm volatile("v_mfma_scale_f32_16x16x128_f8f6f4 %0, %1, %2, %0, %3, %3 op_sel_hi:[0,0,0]" : "+v"(acc[ai][bj][m][n]) : "v"(PG8_CAT(Bt[n])), "v"(PG8_CAT(At[m])), "v"(f8one)); } \
        else { _Pragma("unroll") for (int m = 0; m < 4; ++m) _Pragma("unroll") for (int n = 0; n < 2; ++n) _Pragma("unroll") for (int k = 0; k < 2; ++k) \
            acc[ai][bj][m][n] = __builtin_amdgcn_mfma_f32_16x16x32_bf16(Bt[n][k], At[m][k], acc[ai][bj][m][n], 0, 0, 0); } \
        __builtin_amdgcn_s_setprio(0); } while (0)
#define PG8_WAIT_V(n) asm volatile("s_waitcnt vmcnt(" #n ")" ::: "memory")
#define PG8_WAIT_L(n) asm volatile("s_waitcnt lgkmcnt(" #n ")" ::: "memory")
#define PG8_BAR __builtin_amdgcn_s_barrier()
#define PG8_SCHED __builtin_amdgcn_sched_barrier(0)
    Unit cur, nxt; int ui = 0;
    if (!S.next(0, cur)) return;
    f32x4 acc[2][2][4][2];
#pragma unroll
    for (int a = 0; a < 2; ++a)
#pragma unroll
        for (int b = 0; b < 2; ++b)
#pragma unroll
            for (int m = 0; m < 4; ++m)
#pragma unroll
                for (int n = 0; n < 2; ++n) acc[a][b][m][n] = (f32x4){0.f, 0.f, 0.f, 0.f};
    bf16x8 At[4][2], B0[2][2], B1[2][2];
    const int f8one = 0x7f7f7f7f;
    const char* cA = cur.a; const char* cB = cur.b;
    if constexpr (Epi::LDSBIAS) E.stage_bias(cur, lds + STAGE_BYTES + 4608, wid, lane);
    if constexpr (GA) {
#pragma unroll
        for (int h = 0; h < 2; ++h)
#pragma unroll
            for (int i = 0; i < 2; ++i) { vG[h][i] = (unsigned)g.gidx[(size_t)cur.pm * 256 + 128 * h + RA[i]] * rowb + CB[i]; vGN[h][i] = vG[h][i]; } }
#define PG8_STAGE_A(bufoff, gbase, h, vg) do { if constexpr (GA) PG8_STAGE(bufoff, gbase, (vg)[h]); else PG8_STAGE(bufoff, (gbase) + (h) * hstepA, voffA); } while (0)
    PG8_STAGE(PG8_SB(0, 0), cB, voffB); PG8_STAGE(PG8_SB(0, 1), cB + hstepB, voffB); PG8_STAGE_A(PG8_SA(0, 0), cA, 0, vG); PG8_STAGE_A(PG8_SA(0, 1), cA, 1, vG);
    if (wr == 1) PG8_BAR;
    PG8_WAIT_V(2); PG8_BAR;
    PG8_STAGE(PG8_SB(1, 0), cB + kstep, voffB); PG8_STAGE_A(PG8_SA(1, 0), cA + kstep, 0, vG); PG8_STAGE(PG8_SB(1, 1), cB + hstepB + kstep, voffB);
    PG8_WAIT_V(6); PG8_BAR;
    for (;;) {
        const bool has_next = S.next(ui + 1, nxt);
        const char* nA = has_next ? nxt.a : cA; const char* nB = has_next ? nxt.b : cB;
        if constexpr (Epi::LDSBIAS) { if (ui > 0) E.stage_bias(cur, lds + STAGE_BYTES + 4608 + (ui & 1) * 1024, wid, lane); }
        if constexpr (GA) { if (has_next && wid == 1) __builtin_amdgcn_global_load_lds((const unsigned*)(g.gidx + (size_t)nxt.pm * 256 + 4 * lane), (LAS unsigned*)(gslot + ((ui + 1) & 1) * 1024), 16, 0, 0); }
#pragma clang loop unroll(disable)
        for (int t = 0; t < nt; t += 2) {
            const bool last = (t == nt - 2);
            const char* a1 = cA + (size_t)(t + 1) * kstep;
            const char* a2 = last ? nA : cA + (size_t)(t + 2) * kstep; const char* b2 = last ? nB : cB + (size_t)(t + 2) * kstep;
            const char* a3 = a2 + kstep; const char* b3 = b2 + kstep;
            unsigned vS[2][2];
            if constexpr (GA) {
                if (last && has_next) { const LAS int* ix = (const LAS int*)(gslot + ((ui + 1) & 1) * 1024);
#pragma unroll
                    for (int h = 0; h < 2; ++h)
#pragma unroll
                        for (int i = 0; i < 2; ++i) vGN[h][i] = (unsigned)ix[128 * h + RA[i]] * rowb + CB[i]; }
#pragma unroll
                for (int h = 0; h < 2; ++h)
#pragma unroll
                    for (int i = 0; i < 2; ++i) vS[h][i] = last ? vGN[h][i] : vG[h][i]; }
            PG8_LDB(B0, 0, 0); PG8_LDB(B1, 0, 1); PG8_SCHED; PG8_LDA(At, 0, 0); PG8_STAGE_A(PG8_SA(1, 1), a1, 1, vG);
            PG8_WAIT_V(8); PG8_WAIT_L(0); PG8_BAR; PG8_MMA(0, 0, At, B0); PG8_MMA(0, 1, At, B1); PG8_BAR; PG8_SCHED;
            PG8_LDA(At, 0, 1); PG8_STAGE(PG8_SB(0, 0), b2, voffB); PG8_STAGE(PG8_SB(0, 1), b2 + hstepB, voffB); PG8_STAGE_A(PG8_SA(0, 0), a2, 0, vS);
            PG8_WAIT_V(8); PG8_WAIT_L(0); PG8_BAR; PG8_MMA(1, 0, At, B0); PG8_MMA(1, 1, At, B1); PG8_BAR; PG8_SCHED;
            PG8_LDB(B0, 1, 0); PG8_LDB(B1, 1, 1); PG8_SCHED; PG8_LDA(At, 1, 0); PG8_STAGE_A(PG8_SA(0, 1), a2, 1, vS);
            PG8_WAIT_V(8); PG8_WAIT_L(0); PG8_BAR; PG8_MMA(0, 0, At, B0); PG8_MMA(0, 1, At, B1); PG8_BAR; PG8_SCHED;
            PG8_LDA(At, 1, 1); PG8_STAGE(PG8_SB(1, 0), b3, voffB); PG8_STAGE(PG8_SB(1, 1), b3 + hstepB, voffB); PG8_STAGE_A(PG8_SA(1, 0), a3, 0, vS);
            PG8_WAIT_V(8); PG8_WAIT_L(0); PG8_BAR; PG8_MMA(1, 0, At, B0); PG8_MMA(1, 1, At, B1); PG8_BAR; PG8_SCHED;
        }
        if constexpr (F8) asm volatile("s_nop 15\n\ts_nop 15" ::: "memory");
        if (wr == 0) PG8_BAR;
        E(acc, cur, wr, wc, fr, fq, Epi::LDSBIAS ? lds + STAGE_BYTES + 4608 + (ui & 1) * 1024 : lds + STAGE_BYTES);
        if (!has_next) break;
#pragma unroll
        for (int a = 0; a < 2; ++a)
#pragma unroll
            for (int b = 0; b < 2; ++b)
#pragma unroll
                for (int m = 0; m < 4; ++m)
#pragma unroll
                    for (int n = 0; n < 2; ++n) acc[a][b][m][n] = (f32x4){0.f, 0.f, 0.f, 0.f};
        cur = nxt; cA = nA; cB = nB; ++ui;
        if constexpr (GA) {
#pragma unroll
            for (int h = 0; h < 2; ++h)
#pragma unroll
                for (int i = 0; i < 2; ++i) vG[h][i] = vGN[h][i]; }
        if (wr == 1) PG8_BAR;
    }
    PG8_WAIT_V(0);
    PG8_BAR;
#undef PG8_SA
#undef PG8_SB
#undef PG8_STAGE
#undef PG8_STAGE_A
#undef PG8_LDA
#undef PG8_LDB
#undef PG8_MMA
#undef PG8_CAT
#undef PG8_WAIT_V
#undef PG8_WAIT_L
#undef PG8_BAR
#undef PG8_SCHED
}

struct DenseOrder {
    const char* A; const char* B; size_t astep, bstep; int nM, nN, G, c;
    __device__ __forceinline__ bool next(int i, Unit& u) const {
        int pm, pn; if (!static_map((long)i * G + c, nM, nN, pm, pn)) return false;
        u.pm = pm; u.pn = pn; u.z = 0; u.a = A + (size_t)pm * astep; u.b = B + (size_t)pn * bstep; return true; }
};
struct BatchOrder {
    const char* A; const char* B; size_t astep, astep2, bstepm, bstepn; int bshift, nM, nN, G, c;
    __device__ __forceinline__ bool next(int i, Unit& u) const {
        int pm, pn; if (!static_map((long)i * G + c, nM, nN, pm, pn)) return false;
        u.pm = pm; u.pn = pn; u.z = 0; u.a = A + (size_t)pm * astep + (size_t)pn * astep2; u.b = B + (size_t)(pm >> bshift) * bstepm + (size_t)pn * bstepn; return true; }
};
struct StackOrder {
    const char* A; const char* B; size_t astep, bstep, azstep, bzstep; int nM, nN, nZ, G, c;
    __device__ __forceinline__ bool next(int i, Unit& u) const {
        const long L = (long)i * G + c; const int per = nM * nN; if (L >= (long)per * nZ) return false;
        const int z = (int)(L / per); int pm, pn; static_map(L - (long)z * per, nM, nN, pm, pn);
        u.pm = pm; u.pn = pn; u.z = z; u.a = A + (size_t)z * azstep + (size_t)pm * astep; u.b = B + (size_t)z * bzstep + (size_t)pn * bstep; return true; }
};
struct FoldOrder {
    const char* A; const char* B; bool m2; int G, c;
    __device__ __forceinline__ bool next(int i, Unit& u) const {
        const long L = (long)i * G + c; if (L >= 1024) return false;
        const int z = (int)(L >> 2), q = (int)(L & 3), l = z >> 6, b = (z >> 2) & 15, h = z & 3;
        if (!m2) { u.pm = 0; u.pn = q; u.z = z; u.a = A + ((size_t)(l * 4096 + b * 256) * 1024 + h * 256); u.b = B + ((size_t)l * 1024 * 1024 + (size_t)q * 256 * 1024 + h * 256); }
        else     { u.pm = q; u.pn = h; u.z = z >> 2; u.a = A + ((size_t)l * 1024 * 1024 + (size_t)q * 256 * 1024 + h * 256); u.b = B + ((size_t)(l * 4096 + b * 256) * 1024 + h * 256); }
        return true; }
};
struct MoeOrder {
    const char* A; const char* B; size_t astep, bstep_e, bstep_n; const LAS int* tile_e; int nM, nN, G, c;
    __device__ __forceinline__ bool next(int i, Unit& u) const {
        int pm, pn; if (!static_map((long)i * G + c, nM, nN, pm, pn)) return false;
        const int e = __builtin_amdgcn_readfirstlane(tile_e[pm]);
        u.pm = pm; u.pn = pn; u.z = e; u.a = A + (size_t)pm * astep; u.b = B + (size_t)e * bstep_e + (size_t)pn * bstep_n; return true; }
};

struct EpiStore {
    static constexpr bool PERM = true, INPLACE = false, LDSBIAS = false;
    bf16* O; int ldc; size_t zstride; const float* bias; int bzs; float scale; int scale_tiles; float accs = 1.0f;
    __device__ __forceinline__ void operator()(f32x4 (&acc)[2][2][4][2], const Unit& u, int wr, int wc, int fr, int fq, LAS unsigned char*) const {
        const int row0 = u.pm * BM + wr * 64 + fr, col0 = u.pn * BM + wc * 32 + 8 * fq;
        bf16* base = O + (size_t)u.z * zstride;
        const float sc = (u.pn < scale_tiles) ? scale : 1.0f;
        f32x4 bv[2][2];
#pragma unroll
        for (int bj = 0; bj < 2; ++bj)
#pragma unroll
            for (int n = 0; n < 2; ++n) bv[bj][n] = bias ? *(const f32x4*)(bias + (size_t)u.z * bzs + col0 + bj * HALF + 4 * n) : (f32x4){0.f, 0.f, 0.f, 0.f};
#pragma unroll
        for (int ai = 0; ai < 2; ++ai)
#pragma unroll
            for (int m = 0; m < 4; ++m) { bf16* rowp = base + (size_t)(row0 + ai * HALF + m * 16) * ldc + col0;
#pragma unroll
                for (int bj = 0; bj < 2; ++bj) { const f32x4 v0 = (acc[ai][bj][m][0] * accs + bv[bj][0]) * sc, v1 = (acc[ai][bj][m][1] * accs + bv[bj][1]) * sc;
                    u32x4 w; w.x = cvt_pk_bf16(v0[0], v0[1]); w.y = cvt_pk_bf16(v0[2], v0[3]); w.z = cvt_pk_bf16(v1[0], v1[1]); w.w = cvt_pk_bf16(v1[2], v1[3]);
                    *(u32x4*)(rowp + bj * HALF) = w; } }
    }
};
template <bool LB> struct EpiStore8T {
    static constexpr bool PERM = true, INPLACE = false, LDSBIAS = LB;
    unsigned char* O; int ldc; float scale; const float* bias = nullptr; int bzs = 0; float accs = 1.0f; size_t zstride = 0;
    __device__ __forceinline__ void stage_bias(const Unit& u, LAS unsigned char* slot, int wid, int lane) const {
        if (wid == 0) __builtin_amdgcn_global_load_lds((const unsigned*)(bias + (size_t)u.z * bzs + u.pn * BM + 4 * lane), (LAS unsigned*)slot, 16, 0, 0); }
    __device__ __forceinline__ void operator()(f32x4 (&acc)[2][2][4][2], const Unit& u, int wr, int wc, int fr, int fq, LAS unsigned char* xl) const {
        const int row0 = u.pm * BM + wr * 64 + fr, col0 = u.pn * BM + wc * 32 + 8 * fq;
        f32x4 bv[2][2];
#pragma unroll
        for (int bj = 0; bj < 2; ++bj)
#pragma unroll
            for (int n = 0; n < 2; ++n) { if constexpr (LB) bv[bj][n] = *(const LAS f32x4*)(xl + (wc * 32 + 8 * fq + bj * HALF + 4 * n) * 4);
                else bv[bj][n] = bias ? *(const f32x4*)(bias + (size_t)u.z * bzs + col0 + bj * HALF + 4 * n) : (f32x4){0.f, 0.f, 0.f, 0.f}; }
#pragma unroll
        for (int ai = 0; ai < 2; ++ai)
#pragma unroll
            for (int m = 0; m < 4; ++m) { unsigned char* rowp = O + (size_t)u.z * zstride + (size_t)(row0 + ai * HALF + m * 16) * ldc + col0;
#pragma unroll
                for (int bj = 0; bj < 2; ++bj) { const f32x4 v0 = (acc[ai][bj][m][0] * accs + bv[bj][0]) * scale, v1 = (acc[ai][bj][m][1] * accs + bv[bj][1]) * scale;
                    u32x2 w; w.x = cvt_pk4_fp8(v0[0], v0[1], v0[2], v0[3]); w.y = cvt_pk4_fp8(v1[0], v1[1], v1[2], v1[3]);
                    *(u32x2*)(rowp + bj * HALF) = w; } }
    }
};
typedef EpiStore8T<false> EpiStore8;
struct EpiSwiglu {
    static constexpr bool PERM = true, INPLACE = false, LDSBIAS = true;
    unsigned char* HID; const float* b1; float accs;
    __device__ __forceinline__ void stage_bias(const Unit& u, LAS unsigned char* slot, int wid, int lane) const {
        if (wid == 0) __builtin_amdgcn_global_load_lds((const unsigned*)(b1 + (size_t)u.z * 2048 + (lane >> 5) * 1024 + u.pn * 128 + 4 * (lane & 31)), (LAS unsigned*)slot, 16, 0, 0); }
    __device__ __forceinline__ void operator()(f32x4 (&acc)[2][2][4][2], const Unit& u, int wr, int wc, int fr, int fq, LAS unsigned char* xl) const {
        const int row0 = u.pm * BM + wr * 64 + fr, j0 = u.pn * 128 + wc * 32 + 8 * fq;
        f32x4 bgv[2], buv[2];
#pragma unroll
        for (int n = 0; n < 2; ++n) { bgv[n] = *(const LAS f32x4*)(xl + (wc * 32 + 8 * fq + 4 * n) * 4); buv[n] = *(const LAS f32x4*)(xl + (128 + wc * 32 + 8 * fq + 4 * n) * 4); }
#pragma unroll
        for (int ai = 0; ai < 2; ++ai)
#pragma unroll
            for (int m = 0; m < 4; ++m) { float h[8];
#pragma unroll
                for (int n = 0; n < 2; ++n) { const f32x4 gt = acc[ai][0][m][n] * accs + bgv[n], up = acc[ai][1][m][n] * accs + buv[n];
#pragma unroll
                    for (int q = 0; q < 4; ++q) { const float gc = fminf(gt[q], 7.0f), uc = fminf(fmaxf(up[q], -7.0f), 7.0f); h[4 * n + q] = (uc + 1.0f) * gc * fsigmoid(1.702f * gc); } }
                u32x2 w; w.x = cvt_pk4_fp8(h[0], h[1], h[2], h[3]); w.y = cvt_pk4_fp8(h[4], h[5], h[6], h[7]);
                *(u32x2*)(HID + (size_t)(row0 + ai * HALF + m * 16) * DFF + j0) = w; }
    }
};
struct EpiSoftmax {
    static constexpr bool PERM = true, INPLACE = true, LDSBIAS = false;
    unsigned char* P; float sscale;
    __device__ __forceinline__ void operator()(f32x4 (&acc)[2][2][4][2], const Unit& u, int wr, int wc, int fr, int fq, LAS unsigned char* xl) const {
        LAS f32x2* X = (LAS f32x2*)xl;
#pragma unroll
        for (int ai = 0; ai < 2; ++ai)
#pragma unroll
            for (int bj = 0; bj < 2; ++bj)
#pragma unroll
                for (int m = 0; m < 4; ++m)
#pragma unroll
                    for (int n = 0; n < 2; ++n) acc[ai][bj][m][n] = acc[ai][bj][m][n] * sscale;
        float mw[2][4];
#pragma unroll
        for (int ai = 0; ai < 2; ++ai)
#pragma unroll
            for (int m = 0; m < 4; ++m) { float mx = -3.0e38f;
#pragma unroll
                for (int bj = 0; bj < 2; ++bj)
#pragma unroll
                    for (int n = 0; n < 2; ++n) { const f32x4 x = acc[ai][bj][m][n]; mx = fmaxf(mx, fmaxf(fmaxf(x[0], x[1]), fmaxf(x[2], x[3]))); }
                mx = fmaxf(mx, __shfl_xor(mx, 16)); mx = fmaxf(mx, __shfl_xor(mx, 32));
                float s = 0.f;
#pragma unroll
                for (int bj = 0; bj < 2; ++bj)
#pragma unroll
                    for (int n = 0; n < 2; ++n)
#pragma unroll
                        for (int q = 0; q < 4; ++q) { const float e = __expf(acc[ai][bj][m][n][q] - mx); acc[ai][bj][m][n][q] = e; s += e; }
                s += __shfl_xor(s, 16); s += __shfl_xor(s, 32);
                mw[ai][m] = mx;
                if (fq == 0) X[(ai * HALF + wr * 64 + m * 16 + fr) * 4 + wc] = (f32x2){mx, s};
            }
        asm volatile("s_waitcnt lgkmcnt(0)" ::: "memory"); __builtin_amdgcn_s_barrier(); asm volatile("" ::: "memory");
        const int row0 = u.pm * BM + wr * 64 + fr, col0 = u.pn * BM + wc * 32 + 8 * fq;
#pragma unroll
        for (int ai = 0; ai < 2; ++ai)
#pragma unroll
            for (int m = 0; m < 4; ++m) { const int r = ai * HALF + wr * 64 + m * 16 + fr;
                const f32x2 a = X[r * 4 + 0], b = X[r * 4 + 1], c = X[r * 4 + 2], d = X[r * 4 + 3];
                const float mt = fmaxf(fmaxf(a.x, b.x), fmaxf(c.x, d.x));
                const float st = a.y * __expf(a.x - mt) + b.y * __expf(b.x - mt) + c.y * __expf(c.x - mt) + d.y * __expf(d.x - mt);
                const float sc = __expf(mw[ai][m] - mt) * __builtin_amdgcn_rcpf(st) * 256.0f;
                unsigned char* rowp = P + (size_t)(row0 + ai * HALF + m * 16) * D + col0;
#pragma unroll
                for (int bj = 0; bj < 2; ++bj) { const f32x4 e0 = acc[ai][bj][m][0] * sc, e1 = acc[ai][bj][m][1] * sc;
                    u32x2 w; w.x = cvt_pk4_fp8(e0[0], e0[1], e0[2], e0[3]); w.y = cvt_pk4_fp8(e1[0], e1[1], e1[2], e1[3]);
                    *(u32x2*)(rowp + bj * HALF) = w; } }
    }
};
}

constexpr size_t MiB = 1u << 20;
constexpr size_t WS_CTL = 0, CTL_ZERO_BYTES = 1 * MiB;
constexpr size_t WS_TOPI = 1 * MiB, WS_TOPW = 2 * MiB, WS_POSMAP = 3 * MiB, WS_GATES = 4 * MiB  , WS_CNT = 6 * MiB  , WS_TILEE = 7 * MiB  , WS_K2 = 8 * MiB  , WS_WRT = 9 * MiB  , WS_ROWTOK = 10 * MiB  ;
constexpr size_t WS_W = 16 * MiB;
constexpr size_t W_EVIN = WS_W, W_EVOUT = W_EVIN + 14 * MiB, W_GATE = W_EVOUT + 6 * MiB, W_ODIN = W_GATE + 1 * MiB, W_ODOUT = W_ODIN + 12 * MiB;
constexpr size_t W_Q = W_ODOUT + 4 * MiB, W_K = W_Q + 8 * MiB, W_V = W_K + 8 * MiB, W_O = W_V + 8 * MiB, W_1 = W_O + 8 * MiB, W_2 = W_1 + 512 * MiB, W_END = W_2 + 256 * MiB;
static_assert(W_END <= 880 * MiB, "weights");
constexpr size_t WS_MEMB = 880 * MiB, WS_KM = 888 * MiB, WS_VT = 920 * MiB, WS_XB = 960 * MiB, WS_MIX = 1088 * MiB, WS_R = 1216 * MiB, WS_Y = 2316 * MiB, WS_XR8 = 2508 * MiB, WS_M1 = 2572 * MiB, WS_M2 = 2636 * MiB, WS_END = 2700 * MiB;
constexpr size_t R_Z = WS_R, R_U = WS_R + 448 * MiB, R_AG = WS_R + 576 * MiB, R_INP = WS_R + 832 * MiB, R_HB = WS_R + 448 * MiB;
constexpr size_t R_Q = WS_R, R_P = WS_R + 128 * MiB, R_O = WS_R + 256 * MiB, R_XG = WS_R, R_HID = WS_R + 264 * MiB, R_EO = WS_R + 528 * MiB, R_XA8 = WS_R + 320 * MiB;
static_assert(R_EO + 528 * MiB <= WS_Y && (size_t)MAXMT * 256 * 1024 * 2 <= 528 * MiB, "scratch region");
constexpr int CW_BAR = 4096;

constexpr int LDS_BYTES = 147456;
constexpr int XCH_OFF = 131072;
constexpr int MISC_OFF = LDS_BYTES - 256;
constexpr int NWAVES = 8;

#define XB_TMO      128
#define XB_XCNT(j)  (256  + 64 * (j))
#define XB_XSUB(j)  (1280 + 64 * (j))
#define XB_XGEN(j)  (2304 + 64 * (j))
#define XB_TOP      3328
#define XB_TOPGEN   3392
#define XCD_BAR_WORDS 3456
#define XB_SPIN_CAP (1u << 18)
__device__ __forceinline__ unsigned xb_ld(unsigned* p)              { return __hip_atomic_load(p, __ATOMIC_RELAXED, __HIP_MEMORY_SCOPE_AGENT); }
__device__ __forceinline__ unsigned xb_add(unsigned* p, unsigned v) { return __hip_atomic_fetch_add(p, v, __ATOMIC_RELAXED, __HIP_MEMORY_SCOPE_AGENT); }
__device__ __forceinline__ unsigned xb_xcc_id() { return (unsigned)__builtin_amdgcn_s_getreg((3 << 11) | 20) & 0xFu; }
#define XB_SPIN(cond, bar) do { unsigned _sp = 0; while (cond) { __builtin_amdgcn_s_sleep(1); \
    if ((++_sp & 255u) == 0u) { if (xb_ld(&(bar)[XB_TMO])) break; if (_sp > XB_SPIN_CAP) { atomicAdd(&(bar)[XB_TMO], 1u); break; } } } } while (0)
struct XcdBarrier { unsigned* bar; unsigned x; volatile LAS unsigned* st; int wave; };
__device__ __forceinline__ XcdBarrier xcd_barrier_post(unsigned* bar, volatile LAS unsigned* st, int wave) {
    XcdBarrier b; b.bar = bar; b.x = xb_xcc_id(); b.st = st; b.wave = wave;
    if (wave == 0 && lane_id_opaque() == 0) (void)xb_add(&bar[XB_XCNT(b.x)], 1u);
    return b;
}
__device__ __forceinline__ void xcd_barrier_complete(unsigned* bar, unsigned x, unsigned& nloc, unsigned& nx) {
    const unsigned G = gridDim.x * gridDim.y * gridDim.z;
    unsigned sum, cnt, mine, sp = 0u;
    for (;;) {
        sum = 0u; cnt = 0u; mine = 0u;
#pragma unroll
        for (unsigned j = 0; j < 16; ++j) { const unsigned c = xb_ld(&bar[XB_XCNT(j)]); sum += c; cnt += (c > 0u) ? 1u : 0u; mine = (j == x) ? c : mine; }
        if (sum == G) break;
        __builtin_amdgcn_s_sleep(1);
        if ((++sp & 255u) == 0u) { if (xb_ld(&bar[XB_TMO])) break; if (sp > XB_SPIN_CAP) { atomicAdd(&bar[XB_TMO], 1u); break; } }
    }
    nloc = mine > 0u ? mine : 1u; nx = cnt > 0u ? cnt : 1u;
}
__device__ __forceinline__ void xcd_barrier(const XcdBarrier& b) {
    asm volatile("s_waitcnt vmcnt(0)" ::: "memory");
    __syncthreads();
    if (b.wave == 0 && lane_id_opaque() == 0) {
        unsigned* bar = b.bar;
        __builtin_amdgcn_s_waitcnt(0);
        unsigned nloc = b.st[0], nx = b.st[1];
        if (nloc == 0u) { xcd_barrier_complete(bar, b.x, nloc, nx); b.st[0] = nloc; b.st[1] = nx; }
        const unsigned old = xb_add(&bar[XB_XSUB(b.x)], 1u);
        const unsigned gen = old / nloc;
        if (old + 1u == (gen + 1u) * nloc) {
            __builtin_amdgcn_fence(__ATOMIC_RELEASE, "agent");
            asm volatile("s_waitcnt vmcnt(0)" ::: "memory");
            const unsigned og = xb_add(&bar[XB_TOP], 1u);
            const unsigned tg = og / nx;
            if (og + 1u == (tg + 1u) * nx) xb_add(&bar[XB_TOPGEN], 1u);
            else XB_SPIN(xb_ld(&bar[XB_TOPGEN]) == tg, bar);
            __builtin_amdgcn_fence(__ATOMIC_ACQUIRE, "agent");
            xb_add(&bar[XB_XGEN(b.x)], 1u);
            asm volatile("s_waitcnt vmcnt(0)" ::: "memory");
        } else {
            XB_SPIN(xb_ld(&bar[XB_XGEN(b.x)]) == gen, bar);
            __builtin_amdgcn_fence(__ATOMIC_ACQUIRE, "agent");
            asm volatile("s_waitcnt vmcnt(0)" ::: "memory");
        }
    }
    __syncthreads();
}

#define MFMA16(a, b, c) __builtin_amdgcn_mfma_f32_16x16x32_bf16(a, b, c, 0, 0, 0)
__device__ __forceinline__ bf16x8 tr_frag(const LAS bf16* T, int P, int r0, int c0, int fr, int fq) {
    const LAS bf16* p = T + (r0 + 8 * fq + (fr >> 2)) * P + c0 + 4 * (fr & 3);
    const bf16x4 a = __builtin_amdgcn_ds_read_tr16_b64_v4i16((LAS bf16x4*)p), b = __builtin_amdgcn_ds_read_tr16_b64_v4i16((LAS bf16x4*)(p + 4 * P));
    return __builtin_shufflevector(a, b, 0, 1, 2, 3, 4, 5, 6, 7); }
__device__ __forceinline__ void unpack8(const u32x4 w, float (&o)[8]) { o[0] = bf_lo(w.x); o[1] = bf_hi(w.x); o[2] = bf_lo(w.y); o[3] = bf_hi(w.y); o[4] = bf_lo(w.z); o[5] = bf_hi(w.z); o[6] = bf_lo(w.w); o[7] = bf_hi(w.w); }
__device__ __forceinline__ u32x4 pack8(const float (&o)[8]) { u32x4 w; w.x = cvt_pk_bf16(o[0], o[1]); w.y = cvt_pk_bf16(o[2], o[3]); w.z = cvt_pk_bf16(o[4], o[5]); w.w = cvt_pk_bf16(o[6], o[7]); return w; }
struct Ctx { LAS unsigned char* lds; int tid, lane, wave, bid, G; };

__device__ __forceinline__ void tr_load(f32x4 (&v)[16], const float* W, int srcN, int k0, int n0, int lane) {
#pragma unroll
    for (int i = 0; i < 16; ++i) v[i] = *(const f32x4*)(W + (size_t)(k0 + 4 * i + (lane >> 4)) * srcN + n0 + 4 * (lane & 15));
}
__device__ __forceinline__ void tr_store(const f32x4 (&v)[16], int k0, bf16* WT, int dstK, int drow0, LAS float* scr, int lane, float f8scale) {
#pragma unroll
    for (int i = 0; i < 16; ++i) { LAS float* d = scr + (4 * i + (lane >> 4)) * 65 + 4 * (lane & 15); d[0] = v[i][0]; d[1] = v[i][1]; d[2] = v[i][2]; d[3] = v[i][3]; }
    LDS_WAIT();
    const int c = lane & 7;
    if (f8scale != 0.f) {
        unsigned char* W8 = (unsigned char*)WT;
#pragma unroll
        for (int j = 0; j < 8; ++j) { const int n = (lane >> 3) + 8 * j; const LAS float* sp = scr + (8 * c) * 65 + n;
            u32x2 o; o.x = cvt_pk4_fp8(sp[0 * 65] * f8scale, sp[1 * 65] * f8scale, sp[2 * 65] * f8scale, sp[3 * 65] * f8scale); o.y = cvt_pk4_fp8(sp[4 * 65] * f8scale, sp[5 * 65] * f8scale, sp[6 * 65] * f8scale, sp[7 * 65] * f8scale);
            *(u32x2*)(W8 + (size_t)(drow0 + n) * dstK + k0 + 8 * c) = o; }
    } else {
#pragma unroll
        for (int j = 0; j < 8; ++j) { const int n = (lane >> 3) + 8 * j; const LAS float* sp = scr + (8 * c) * 65 + n;
            u32x4 o; o.x = cvt_pk_bf16(sp[0 * 65], sp[1 * 65]); o.y = cvt_pk_bf16(sp[2 * 65], sp[3 * 65]); o.z = cvt_pk_bf16(sp[4 * 65], sp[5 * 65]); o.w = cvt_pk_bf16(sp[6 * 65], sp[7 * 65]);
            *(u32x4*)(WT + (size_t)(drow0 + n) * dstK + k0 + 8 * c) = o; }
    }
    LDS_WAIT();
}
__device__ __forceinline__ void conv_group(const Ctx& X, const float* src, int nb, int K, int N, int srcN, size_t sbs, bf16* dst, size_t dbs, int map, float f8scale = 0.f) {
    LAS float* scr = (LAS float*)(X.lds + X.wave * 16896);
    const int gw = X.bid * NWAVES + X.wave, NGW = X.G * NWAVES;
    const int nblk = N / 64, ipb = (K / 64) * nblk; const long total = (long)nb * ipb;
    f32x4 v[16], vn[16];
    long it = gw;
    if (it < total) { const int bt = (int)(it / ipb), r = (int)(it % ipb); tr_load(v, src + (size_t)bt * sbs, srcN, 64 * (r / nblk), 64 * (r % nblk), X.lane); }
    for (; it < total; it += NGW) {
        const int bt = (int)(it / ipb), r = (int)(it % ipb), kb = r / nblk, n0 = 64 * (r % nblk);
        const long itn = it + NGW;
        if (itn < total) { const int btn = (int)(itn / ipb), rn = (int)(itn % ipb); tr_load(vn, src + (size_t)btn * sbs, srcN, 64 * (rn / nblk), 64 * (rn % nblk), X.lane); }
        __builtin_amdgcn_sched_barrier(0);
        int drow = n0; if (map == 1) { const int j = n0 & 1023; drow = (j >> 7) * 256 + (n0 >= 1024 ? 128 : 0) + (j & 127); }
        bf16* dp = f8scale != 0.f ? (bf16*)((unsigned char*)dst + (size_t)bt * dbs) : dst + (size_t)bt * dbs;
        tr_store(v, 64 * kb, dp, K, drow, scr, X.lane, f8scale);
        __builtin_amdgcn_sched_barrier(0);
#pragma unroll
        for (int i = 0; i < 16; ++i) v[i] = vn[i];
    }
}
__device__ __forceinline__ void cvt_flat(const Ctx& X, const float* src, bf16* dst, size_t n) {
    const size_t gt = (size_t)X.bid * 512 + X.tid, NT = (size_t)X.G * 512;
    for (size_t i = gt; i < n / 8; i += NT) { const f32x4 a = *(const f32x4*)(src + i * 8), b = *(const f32x4*)(src + i * 8 + 4);
        u32x4 w; w.x = cvt_pk_bf16(a[0], a[1]); w.y = cvt_pk_bf16(a[2], a[3]); w.z = cvt_pk_bf16(b[0], b[1]); w.w = cvt_pk_bf16(b[2], b[3]); *(u32x4*)(dst + i * 8) = w; }
}

__device__ __forceinline__ void cvt_flat8(const Ctx& X, const float* src, unsigned char* dst, size_t n, float sc = 1.0f) {
    const size_t gt = (size_t)X.bid * 512 + X.tid, NT = (size_t)X.G * 512;
    for (size_t i = gt; i < n / 8; i += NT) { const f32x4 a = *(const f32x4*)(src + i * 8), b = *(const f32x4*)(src + i * 8 + 4);
        u32x2 w; w.x = cvt_pk4_fp8(a[0] * sc, a[1] * sc, a[2] * sc, a[3] * sc); w.y = cvt_pk4_fp8(b[0] * sc, b[1] * sc, b[2] * sc, b[3] * sc); *(u32x2*)(dst + i * 8) = w; }
}

template <bool MOE, int ROWS>
__device__ __forceinline__ void ln_phase(const Ctx& X, const float* xin_f32, const bf16* f, const int* posmap, const float* topw, const float* g, const float* b, float* xout_f32, bf16* xb, unsigned char* xr8, unsigned char* x8 = nullptr) {
    const int gw = X.bid * NWAVES + X.wave, NGW = X.G * NWAVES, lane = X.lane;
    f32x4 gv[4], bv[4];
#pragma unroll
    for (int j = 0; j < 4; ++j) { gv[j] = *(const f32x4*)(g + 4 * lane + 256 * j); bv[j] = *(const f32x4*)(b + 4 * lane + 256 * j); }
    for (int base = gw * ROWS; base < T; base += NGW * ROWS) {
        f32x4 v[ROWS][4];
#pragma unroll
        for (int r = 0; r < ROWS; ++r)
#pragma unroll
            for (int j = 0; j < 4; ++j) { const size_t o_ = (size_t)(base + r) * D + 4 * lane + 256 * j;
                if (xin_f32) v[r][j] = *(const f32x4*)(xin_f32 + o_);
                else { const u32x2 w = *(const u32x2*)(xb + o_); const unsigned q8 = *(const unsigned*)(xr8 + o_);
                    v[r][j] = (f32x4){bf_lo(w.x), bf_hi(w.x), bf_lo(w.y), bf_hi(w.y)} + (f32x4){__builtin_amdgcn_cvt_f32_fp8(q8, 0), __builtin_amdgcn_cvt_f32_fp8(q8, 1), __builtin_amdgcn_cvt_f32_fp8(q8, 2), __builtin_amdgcn_cvt_f32_fp8(q8, 3)} * XR_INV; } }
        if (MOE) {
            const int vz = X.tid >> 10;
            unsigned fw[ROWS][4][4]; f32x4 tw[ROWS];
#pragma unroll
            for (int r = 0; r < ROWS; ++r) { const int4 ps = *(const int4*)(posmap + (size_t)(base + r) * 4 + vz); tw[r] = *(const f32x4*)(topw + (size_t)(base + r) * 4 + vz);
                const int pp[4] = {ps.x, ps.y, ps.z, ps.w};
#pragma unroll
                for (int s = 0; s < 4; ++s)
#pragma unroll
                    for (int j = 0; j < 4; ++j) fw[r][s][j] = *(const unsigned*)((const unsigned char*)f + (size_t)pp[s] * D + 4 * lane + 256 * j); }
#pragma unroll
            for (int r = 0; r < ROWS; ++r)
#pragma unroll
                for (int j = 0; j < 4; ++j) { v[r][j] = v[r][j] * DN_ALPHA;
#pragma unroll
                    for (int s = 0; s < 4; ++s) { const unsigned w = fw[r][s][j]; const float ts = tw[r][s] * (1.0f / EO_SCALE);
                        v[r][j] += (f32x4){__builtin_amdgcn_cvt_f32_fp8(w, 0), __builtin_amdgcn_cvt_f32_fp8(w, 1), __builtin_amdgcn_cvt_f32_fp8(w, 2), __builtin_amdgcn_cvt_f32_fp8(w, 3)} * ts; } }
        } else {
            u32x2 fw[ROWS][4];
#pragma unroll
            for (int r = 0; r < ROWS; ++r)
#pragma unroll
                for (int j = 0; j < 4; ++j) fw[r][j] = *(const u32x2*)(f + (size_t)(base + r) * D + 4 * lane + 256 * j);
#pragma unroll
            for (int r = 0; r < ROWS; ++r)
#pragma unroll
                for (int j = 0; j < 4; ++j) { const u32x2 w = fw[r][j]; v[r][j] = v[r][j] * DN_ALPHA + (f32x4){bf_lo(w.x), bf_hi(w.x), bf_lo(w.y), bf_hi(w.y)}; }
        }
        float mean[ROWS], rstd[ROWS];
#pragma unroll
        for (int r = 0; r < ROWS; ++r) { float s = 0.f;
#pragma unroll
            for (int j = 0; j < 4; ++j) s += (v[r][j][0] + v[r][j][1]) + (v[r][j][2] + v[r][j][3]);
            mean[r] = wave_sum(s) * (1.f / D); }
#pragma unroll
        for (int r = 0; r < ROWS; ++r) { float s2 = 0.f;
#pragma unroll
            for (int j = 0; j < 4; ++j) { v[r][j] = v[r][j] - mean[r]; s2 += (v[r][j][0] * v[r][j][0] + v[r][j][1] * v[r][j][1]) + (v[r][j][2] * v[r][j][2] + v[r][j][3] * v[r][j][3]); }
            rstd[r] = 1.f / sqrtf(wave_sum(s2) * (1.f / D) + LN_EPS); }
#pragma unroll
        for (int r = 0; r < ROWS; ++r)
#pragma unroll
            for (int j = 0; j < 4; ++j) { const f32x4 o = v[r][j] * rstd[r] * gv[j] + bv[j];
                const size_t o_ = (size_t)(base + r) * D + 4 * lane + 256 * j;
                if (xout_f32) { *(f32x4*)(xout_f32 + o_) = o; continue; }
                u32x2 w; w.x = cvt_pk_bf16(o[0], o[1]); w.y = cvt_pk_bf16(o[2], o[3]); *(u32x2*)(xb + o_) = w;
                *(unsigned*)(xr8 + o_) = cvt_pk4_fp8((o[0] - bf_lo(w.x)) * XR_SCALE, (o[1] - bf_hi(w.x)) * XR_SCALE, (o[2] - bf_lo(w.y)) * XR_SCALE, (o[3] - bf_hi(w.y)) * XR_SCALE);
                if (x8) *(unsigned*)(x8 + (size_t)(base + r) * D + 4 * lane + 256 * j) = cvt_pk4_fp8(o[0], o[1], o[2], o[3]); }
    }
}

__device__ __forceinline__ void ya_phase(const Ctx& X, const bf16* Z, const float* conv_a, bf16* Y) {
    const size_t gt = (size_t)X.bid * 512 + X.tid, NT = (size_t)X.G * 512, items = (size_t)T * 64;
    const int cg = (int)(gt & 63), c0 = cg * 8;
    f32x4 w0[3], w1[3];
#pragma unroll
    for (int j = 0; j < 3; ++j) { w0[j] = *(const f32x4*)(conv_a + j * 512 + c0); w1[j] = *(const f32x4*)(conv_a + j * 512 + c0 + 4); }
    for (size_t it = gt; it < items; it += 4 * NT) {
        u32x4 rab[4], rac[4][3], rax[4][3];
#pragma unroll
        for (int u = 0; u < 4; ++u) { const int t = (int)((it + u * NT) >> 6), pos = t & (SEQ - 1);
            rab[u] = *(const u32x4*)(Z + (size_t)t * EV_IN + c0);
#pragma unroll
            for (int j = 0; j < 3; ++j) { const bool ok = pos - 2 + j >= 0; const size_t tt = ok ? (size_t)(t - 2 + j) : (size_t)t;
                rac[u][j] = *(const u32x4*)(Z + tt * EV_IN + 512 + c0); rax[u][j] = *(const u32x4*)(Z + tt * EV_IN + 1024 + c0);
                if (!ok) { rac[u][j] = (u32x4){0u, 0u, 0u, 0u}; } } }
        __builtin_amdgcn_sched_barrier(0);
#pragma unroll
        for (int u = 0; u < 4; ++u) { const int t = (int)((it + u * NT) >> 6); float ab[8], acc[8];
            unpack8(rab[u], ab);
#pragma unroll
            for (int q = 0; q < 8; ++q) acc[q] = 0.f;
#pragma unroll
            for (int j = 0; j < 3; ++j) { float ac[8], ax[8]; unpack8(rac[u][j], ac); unpack8(rax[u][j], ax);
#pragma unroll
                for (int q = 0; q < 4; ++q) { acc[q] += w0[j][q] * (ac[q] * ax[q]); acc[4 + q] += w1[j][q] * (ac[4 + q] * ax[4 + q]); } }
#pragma unroll
            for (int q = 0; q < 8; ++q) acc[q] *= ab[q];
            *(u32x4*)(Y + (size_t)t * EV_Y + c0) = pack8(acc); }
    }
}

__device__ __forceinline__ float gelu_tanh(float x) { const float u = 0.7978845608028654f * (x + 0.044715f * x * x * x); const float e = __expf(2.f * u); const float th = 1.f - 2.f * __builtin_amdgcn_rcpf(e + 1.f); return 0.5f * x * (1.f + th); }
__device__ __forceinline__ void lru_phase(const Ctx& X, const bf16* Z, const bf16* WG  , const float* conv_b, const float* conv_bb, const float* br, const float* bi, const float* k2, bf16* Y) {
    constexpr int RS = 136;
    LAS bf16* WS = (LAS bf16*)X.lds;
    LAS bf16* US = (LAS bf16*)(X.lds + 34816);
    LAS f32x2* AH = (LAS f32x2*)(X.lds + 52224);
    LAS bf16* BG = (LAS bf16*)(X.lds + 84992);
    LAS bf16* YS = (LAS bf16*)(X.lds + 93184);
    LAS f32x2* EX = (LAS f32x2*)(X.lds + 101376);
    const int tid = X.tid, lane = X.lane, w = X.wave, fr = lane & 15, fq = lane >> 4, cg = tid & 15, tb = w & 3, nh = w >> 2;
    for (int unit = X.bid; unit < 256; unit += X.G) {
        const int b = unit >> 4, h = (unit >> 1) & 7, half = unit & 1, hc0 = h * 128, e0 = hc0 + half * 64;
        const size_t row0 = (size_t)b * SEQ;
        __syncthreads();
#pragma unroll
        for (int i = 0; i < 4; ++i) { const int p = tid + 512 * i, n = p >> 4, cp = p & 15; const int srow = (n < 64) ? half * 64 + n : 128 + half * 64 + (n - 64);
            *(LAS u32x4*)(WS + n * RS + cp * 8) = *(const u32x4*)(WG + ((size_t)h * 256 + srow) * 128 + cp * 8); }
        float wcv[4][8], bcv[8];
#pragma unroll
        for (int q = 0; q < 8; ++q) { bcv[q] = conv_bb[hc0 + 8 * cg + q];
#pragma unroll
            for (int j = 0; j < 4; ++j) wcv[j][q] = conv_b[j * 1024 + hc0 + 8 * cg + q]; }
        float brv[2], biv[2], k2v[2];
#pragma unroll
        for (int nbi = 0; nbi < 2; ++nbi) { const int ch = e0 + 16 * (2 * nh + nbi) + fr; brv[nbi] = br[ch]; biv[nbi] = bi[ch]; k2v[nbi] = k2[ch]; }
        float carry = 0.f;
        u32x4 pu[2][4], pg;
#define LRU_LOAD(c) do { _Pragma("unroll") for (int it = 0; it < 2; ++it) { const int t_ = (tid + 512 * it) >> 4; \
                _Pragma("unroll") for (int j = 0; j < 4; ++j) { const int tt = (c) * 64 + t_ - 3 + j; \
                    pu[it][j] = (tt >= 0) ? *(const u32x4*)(Z + (row0 + tt) * EV_IN + 1536 + hc0 + 8 * cg) : (u32x4){0u, 0u, 0u, 0u}; } } \
            pg = *(const u32x4*)(Z + (row0 + (size_t)(c) * 64 + (tid >> 3)) * EV_IN + 2560 + e0 + 8 * (tid & 7)); } while (0)
        LRU_LOAD(0);
        for (int c = 0; c < 64; ++c) {
#pragma unroll
            for (int it = 0; it < 2; ++it) { const int t = (tid + 512 * it) >> 4; float u8[8];
#pragma unroll
                for (int q = 0; q < 8; ++q) u8[q] = bcv[q];
#pragma unroll
                for (int j = 0; j < 4; ++j) { float x8[8]; unpack8(pu[it][j], x8);
#pragma unroll
                    for (int q = 0; q < 8; ++q) u8[q] += wcv[j][q] * x8[q]; }
                *(LAS u32x4*)(US + t * RS + 8 * cg) = pack8(u8); }
            *(LAS u32x4*)(BG + (tid >> 3) * 64 + 8 * (tid & 7)) = pg;
            WG_BAR();
            if (c + 1 < 64) LRU_LOAD(c + 1);
            { bf16x8 af[4];
#pragma unroll
              for (int ks = 0; ks < 4; ++ks) af[ks] = *(const LAS bf16x8*)(US + (16 * tb + fr) * RS + 32 * ks + 8 * fq);
#pragma unroll
              for (int nbi = 0; nbi < 2; ++nbi) { const int nb = 2 * nh + nbi; f32x4 aR = (f32x4){0.f, 0.f, 0.f, 0.f}, aI = (f32x4){0.f, 0.f, 0.f, 0.f};
#pragma unroll
                for (int ks = 0; ks < 4; ++ks) { const bf16x8 wr_ = *(const LAS bf16x8*)(WS + (16 * nb + fr) * RS + 32 * ks + 8 * fq), wi_ = *(const LAS bf16x8*)(WS + (64 + 16 * nb + fr) * RS + 32 * ks + 8 * fq);
                    aR = MFMA16(af[ks], wr_, aR); aI = MFMA16(af[ks], wi_, aI); }
#pragma unroll
                for (int r = 0; r < 4; ++r) { const int t = 16 * tb + 4 * fq + r, ch = 16 * nb + fr;
                    const float rg = fsigmoid(aR[r] + brv[nbi]), ig = fsigmoid(aI[r] + biv[nbi]); const float a = __builtin_amdgcn_exp2f(rg * k2v[nbi]);
                    const float uu = bf1(US[t * RS + half * 64 + ch]);
                    AH[t * 64 + ch] = (f32x2){a, __builtin_sqrtf(fmaxf(1.0f - a * a, 0.f)) * (ig * uu)}; } } }
            WG_BAR();
            { float av[8], xv[8]; float A = 1.f, H = 0.f;
#pragma unroll
              for (int i = 0; i < 8; ++i) { const f32x2 e = AH[(8 * w + i) * 64 + lane]; av[i] = e.x; xv[i] = e.y; H = e.x * H + e.y; A *= e.x; }
              LAS f32x2* ex = EX + (c & 1) * 512;
              ex[w * 64 + lane] = (f32x2){A, H};
              WG_BAR();
              float cc = carry, cin = carry;
#pragma unroll
              for (int ww = 0; ww < 8; ++ww) { const f32x2 e = ex[ww * 64 + lane]; if (ww == w) cin = cc; cc = e.x * cc + e.y; }
              carry = cc;
              float hh = cin;
#pragma unroll
              for (int i = 0; i < 8; ++i) { hh = av[i] * hh + xv[i]; const float gv = bf1(BG[(8 * w + i) * 64 + lane]);
                  YS[(8 * w + i) * 64 + lane] = (bf16)(cvt_pk_bf16(gelu_tanh(gv) * hh, 0.f) & 0xffffu); } }
            WG_BAR();
            *(u32x4*)(Y + (row0 + (size_t)c * 64 + (tid >> 3)) * EV_Y + 512 + e0 + 8 * (tid & 7)) = *(const LAS u32x4*)(YS + (tid >> 3) * 64 + 8 * (tid & 7));
        }
#undef LRU_LOAD
    }
    __syncthreads();
}

__device__ __forceinline__ void gates_phase(const Ctx& X, const bf16* xb, const unsigned char* xr8, const float* w_in  , const float* bg, float* GATES) {
    LAS float* w8 = (LAS float*)X.lds;
    for (int idx = X.tid; idx < 8192; idx += 512) { const int k = idx >> 3, g = idx & 7; w8[g * 1024 + k] = w_in[(size_t)k * OD_IN + OD_INP + g]; }
    __syncthreads();
    const int gw = X.bid * NWAVES + X.wave, NGW = X.G * NWAVES, lane = X.lane;
    const float bgl = bg[lane & 7];
    for (int base = gw * 4; base < T; base += NGW * 4) {
        f32x4 v[4][4];
#pragma unroll
        for (int r = 0; r < 4; ++r)
#pragma unroll
            for (int j = 0; j < 4; ++j) { const size_t o_ = (size_t)(base + r) * D + 4 * lane + 256 * j; const u32x2 w = *(const u32x2*)(xb + o_); const unsigned q8 = *(const unsigned*)(xr8 + o_);
                v[r][j] = (f32x4){bf_lo(w.x), bf_hi(w.x), bf_lo(w.y), bf_hi(w.y)} + (f32x4){__builtin_amdgcn_cvt_f32_fp8(q8, 0), __builtin_amdgcn_cvt_f32_fp8(q8, 1), __builtin_amdgcn_cvt_f32_fp8(q8, 2), __builtin_amdgcn_cvt_f32_fp8(q8, 3)} * XR_INV; }
        float mine[4] = {0.f, 0.f, 0.f, 0.f};
#pragma unroll
        for (int g = 0; g < 8; ++g) { f32x4 wv[4];
#pragma unroll
            for (int j = 0; j < 4; ++j) wv[j] = *(const LAS f32x4*)(w8 + g * 1024 + 4 * lane + 256 * j);
#pragma unroll
            for (int r = 0; r < 4; ++r) { float s = 0.f;
#pragma unroll
                for (int j = 0; j < 4; ++j) s += (v[r][j][0] * wv[j][0] + v[r][j][1] * wv[j][1]) + (v[r][j][2] * wv[j][2] + v[r][j][3] * wv[j][3]);
                s = wave_sum(s); if (lane == g) mine[r] = s; } }
        if (lane < 8) {
#pragma unroll
            for (int r = 0; r < 4; ++r) { float val = mine[r] + bgl;
                if (lane >= 4) val = fminf(val, 0.f) - log1pf(__expf(-fabsf(val)));
                GATES[(size_t)(base + r) * 8 + lane] = val; } }
    }
    __syncthreads();
}

__device__ __forceinline__ void mlstm_phase(const Ctx& X, const bf16* ZO, const float* GATES, bf16* HB) {
    constexpr int RS = 136;
    LAS unsigned char* lds = X.lds;
    LAS bf16* KS = (LAS bf16*)(lds);
    constexpr int VS_P = 72;
    LAS bf16* VS = (LAS bf16*)(lds + 34816);
    LAS bf16* CT = (LAS bf16*)(lds + 87040);
    LAS bf16* PS = (LAS bf16*)(lds + 104448) + X.wave * 16 * RS;
    LAS float* SC = (LAS float*)(lds + 139264);
    LAS float *s_a = SC, *s_M = SC + 128, *s_wi = SC + 256, *s_enm = SC + 384, *s_wg = SC + 512, *s_n = SC + 640, *s_misc = SC + 768;
    const int tid = X.tid, lane = X.lane, w = X.wave, fr = lane & 15, fq = lane >> 4;
    for (int unit = X.bid; unit < 256; unit += X.G) {
        const int dvs = unit & 3, bh = unit >> 2, h = bh & 3, b = bh >> 2;
        const size_t row0 = (size_t)b * SEQ;
        const bf16* qbase = ZO + h * 128; const bf16* kbase = ZO + 512 + h * 128; const bf16* vbase = ZO + 1024 + h * 256 + dvs * 64;
        __syncthreads();
        for (int i = tid; i < 64 * RS / 2; i += 512) ((LAS unsigned*)CT)[i] = 0u;
        if (tid < 128) s_n[tid] = 0.f;
        f32x4 accC[4];
#pragma unroll
        for (int i = 0; i < 4; ++i) accC[i] = (f32x4){0.f, 0.f, 0.f, 0.f};
        float nreg = 0.f, m_st = 0.f;
        u32x4 kreg[4], vreg[2]; bf16x8 qn[4]; float gi0 = 0.f, gi1 = 0.f, gf0 = 0.f, gf1 = 0.f;
#define ML_LOAD(c) do { const size_t t0_ = row0 + (size_t)(c) * 128; \
            _Pragma("unroll") for (int i = 0; i < 4; ++i) { const int p = tid + 512 * i; kreg[i] = *(const u32x4*)(kbase + (t0_ + (p >> 4)) * OD_INP + (p & 15) * 8); }     \
            _Pragma("unroll") for (int i = 0; i < 2; ++i) { const int p = tid + 512 * i; vreg[i] = *(const u32x4*)(vbase + (t0_ + (p >> 3)) * OD_INP + (p & 7) * 8); } \
            _Pragma("unroll") for (int ks = 0; ks < 4; ++ks) qn[ks] = *(const bf16x8*)(qbase + (t0_ + 16 * w + fr) * OD_INP + 32 * ks + 8 * fq); \
            if (w == 7) { gi0 = GATES[(t0_ + 2 * lane) * 8 + h]; gi1 = GATES[(t0_ + 2 * lane + 1) * 8 + h]; gf0 = GATES[(t0_ + 2 * lane) * 8 + 4 + h]; gf1 = GATES[(t0_ + 2 * lane + 1) * 8 + 4 + h]; } } while (0)
        ML_LOAD(0);
        for (int c = 0; c < 32; ++c) {
            const size_t t0 = row0 + (size_t)c * 128;
#pragma unroll
            for (int i = 0; i < 4; ++i) { const int p = tid + 512 * i, row = p >> 4, cp = p & 15; *(LAS u32x4*)(KS + row * RS + cp * 8) = kreg[i]; }
#pragma unroll
            for (int i = 0; i < 2; ++i) { const int p = tid + 512 * i, row = p >> 3, cp = p & 7; *(LAS u32x4*)(VS + row * VS_P + cp * 8) = vreg[i]; }
            bf16x8 qc[4];
#pragma unroll
            for (int ks = 0; ks < 4; ++ks) qc[ks] = qn[ks];
            if (w == 7) {
                float sc = gf0 + gf1;
#pragma unroll
                for (int off = 1; off < 64; off <<= 1) { const float t = __shfl_up(sc, off); if (lane >= off) sc += t; }
                const float b1 = sc, b0 = sc - gf1, a0 = gi0 - b0, a1 = gi1 - b1;
                float sm = fmaxf(a0, a1);
#pragma unroll
                for (int off = 1; off < 64; off <<= 1) { const float t = __shfl_up(sm, off); if (lane >= off) sm = fmaxf(sm, t); }
                float prev = __shfl_up(sm, 1); if (lane == 0) prev = -3.0e38f;
                const float M0 = fmaxf(m_st, fmaxf(prev, a0)), M1 = fmaxf(m_st, sm);
                const float Ml = __shfl(M1, 63), bend = __shfl(b1, 63);
                s_a[2 * lane] = a0; s_a[2 * lane + 1] = a1; s_M[2 * lane] = M0; s_M[2 * lane + 1] = M1;
                s_wi[2 * lane] = __expf(m_st - M0); s_wi[2 * lane + 1] = __expf(m_st - M1);
                s_enm[2 * lane] = __expf(-(b0 + M0)); s_enm[2 * lane + 1] = __expf(-(b1 + M1));
                s_wg[2 * lane] = __expf(a0 - Ml); s_wg[2 * lane + 1] = __expf(a1 - Ml);
                if (lane == 0) s_misc[0] = __expf(m_st - Ml);
                m_st = bend + Ml;
            }
            WG_BAR();
            if (c + 1 < 32) ML_LOAD(c + 1);
            const float Mt = s_M[16 * w + fr]; float rs = 0.f;
#pragma unroll
            for (int sb = 0; sb < 8; ++sb) {
                if (sb > w) { *(LAS u32x2*)(PS + fr * RS + 16 * sb + 4 * fq) = (u32x2){0u, 0u}; continue; }
                f32x4 acc = (f32x4){0.f, 0.f, 0.f, 0.f};
#pragma unroll
                for (int ks = 0; ks < 4; ++ks) { const bf16x8 kf = *(const LAS bf16x8*)(KS + (16 * sb + fr) * RS + 32 * ks + 8 * fq); acc = MFMA16(kf, qc[ks], acc); }
                const f32x4 av = *(const LAS f32x4*)(s_a + 16 * sb + 4 * fq); float pv[4];
#pragma unroll
                for (int r = 0; r < 4; ++r) { const int s = 16 * sb + 4 * fq + r, tt = 16 * w + fr; const float e = __expf(av[r] - Mt); const float v = (s <= tt) ? acc[r] * e : 0.f; rs += v; pv[r] = v; }
                *(LAS u32x2*)(PS + fr * RS + 16 * sb + 4 * fq) = (u32x2){cvt_pk_bf16(pv[0], pv[1]), cvt_pk_bf16(pv[2], pv[3])};
            }
            rs += __shfl_xor(rs, 16); rs += __shfl_xor(rs, 32);
            float qn_ = 0.f;
#pragma unroll
            for (int ks = 0; ks < 4; ++ks) { const f32x4 n0 = *(const LAS f32x4*)(s_n + 32 * ks + 8 * fq), n1 = *(const LAS f32x4*)(s_n + 32 * ks + 8 * fq + 4);
                const u32x4 qw = __builtin_bit_cast(u32x4, qc[ks]);
                qn_ += bf_lo(qw.x) * n0[0] + bf_hi(qw.x) * n0[1] + bf_lo(qw.y) * n0[2] + bf_hi(qw.y) * n0[3] + bf_lo(qw.z) * n1[0] + bf_hi(qw.z) * n1[1] + bf_lo(qw.w) * n1[2] + bf_hi(qw.w) * n1[3]; }
            qn_ += __shfl_xor(qn_, 16); qn_ += __shfl_xor(qn_, 32);
            const float wi = s_wi[16 * w + fr], enm = s_enm[16 * w + fr];
            const float den = rs + wi * qn_; const float hden = 1.0f / fmaxf(fabsf(den), enm);
            f32x4 accH[4], accI[4];
#pragma unroll
            for (int i = 0; i < 4; ++i) { accH[i] = (f32x4){0.f, 0.f, 0.f, 0.f}; accI[i] = (f32x4){0.f, 0.f, 0.f, 0.f}; }
#pragma unroll
            for (int ks = 0; ks < 4; ++ks) { if (32 * ks > 16 * w + 15) continue;
                const bf16x8 pf = *(const LAS bf16x8*)(PS + fr * RS + 32 * ks + 8 * fq);
#pragma unroll
                for (int dvb = 0; dvb < 4; ++dvb) { const bf16x8 vf = tr_frag(VS, VS_P, 32 * ks, 16 * dvb, fr, fq); accH[dvb] = MFMA16(vf, pf, accH[dvb]); } }
#pragma unroll
            for (int ks = 0; ks < 4; ++ks)
#pragma unroll
                for (int dvb = 0; dvb < 4; ++dvb) { const bf16x8 cf = *(const LAS bf16x8*)(CT + (16 * dvb + fr) * RS + 32 * ks + 8 * fq); accI[dvb] = MFMA16(cf, qc[ks], accI[dvb]); }
#pragma unroll
            for (int dvb = 0; dvb < 4; ++dvb) { float o[4];
#pragma unroll
                for (int r = 0; r < 4; ++r) o[r] = (accH[dvb][r] + wi * accI[dvb][r]) * hden;
                *(u32x2*)(HB + (t0 + 16 * w + fr) * D + h * 256 + dvs * 64 + 16 * dvb + 4 * fq) = (u32x2){cvt_pk_bf16(o[0], o[1]), cvt_pk_bf16(o[2], o[3])}; }
            const float decay = s_misc[0];
#pragma unroll
            for (int i = 0; i < 4; ++i) accC[i] = accC[i] * decay;
            float nadd = 0.f;
#pragma unroll
            for (int ks = 0; ks < 4; ++ks) { const u32x4 kw = __builtin_bit_cast(u32x4, tr_frag(KS, RS, 32 * ks, 16 * w, fr, fq));
                const f32x4 g0 = *(const LAS f32x4*)(s_wg + 32 * ks + 8 * fq), g1 = *(const LAS f32x4*)(s_wg + 32 * ks + 8 * fq + 4);
                const float f0 = bf_lo(kw.x) * g0[0], f1 = bf_hi(kw.x) * g0[1], f2 = bf_lo(kw.y) * g0[2], f3 = bf_hi(kw.y) * g0[3], f4 = bf_lo(kw.z) * g1[0], f5 = bf_hi(kw.z) * g1[1], f6 = bf_lo(kw.w) * g1[2], f7 = bf_hi(kw.w) * g1[3];
                nadd += ((f0 + f1) + (f2 + f3)) + ((f4 + f5) + (f6 + f7));
                u32x4 sw; sw.x = cvt_pk_bf16(f0, f1); sw.y = cvt_pk_bf16(f2, f3); sw.z = cvt_pk_bf16(f4, f5); sw.w = cvt_pk_bf16(f6, f7);
                const bf16x8 ktw = __builtin_bit_cast(bf16x8, sw);
#pragma unroll
                for (int dvb = 0; dvb < 4; ++dvb) { const bf16x8 vf = tr_frag(VS, VS_P, 32 * ks, 16 * dvb, fr, fq); accC[dvb] = MFMA16(ktw, vf, accC[dvb]); } }
            nadd += __shfl_xor(nadd, 16); nadd += __shfl_xor(nadd, 32);
            nreg = decay * nreg + nadd;
            WG_BAR();
#pragma unroll
            for (int dvb = 0; dvb < 4; ++dvb) *(LAS u32x2*)(CT + (16 * dvb + fr) * RS + 16 * w + 4 * fq) = (u32x2){cvt_pk_bf16(accC[dvb][0], accC[dvb][1]), cvt_pk_bf16(accC[dvb][2], accC[dvb][3])};
            if (fq == 0) s_n[16 * w + fr] = nreg;
        }
#undef ML_LOAD
    }
    __syncthreads();
}

__device__ __forceinline__ void hnorm_phase(const Ctx& X, const bf16* HB, const bf16* ZO, const float* ng, bf16* Y) {
    const int gw = X.bid * NWAVES + X.wave, NGW = X.G * NWAVES, lane = X.lane;
    float gv[16];
#pragma unroll
    for (int j = 0; j < 4; ++j) { const f32x4 t = *(const f32x4*)(ng + 16 * lane + 4 * j); gv[4 * j] = t[0]; gv[4 * j + 1] = t[1]; gv[4 * j + 2] = t[2]; gv[4 * j + 3] = t[3]; }
    for (int base = gw * 4; base < T; base += NGW * 4) {
        u32x4 hw[4][2], ow[4][2];
#pragma unroll
        for (int r = 0; r < 4; ++r)
#pragma unroll
            for (int q = 0; q < 2; ++q) { hw[r][q] = *(const u32x4*)(HB + (size_t)(base + r) * D + 16 * lane + 8 * q); ow[r][q] = *(const u32x4*)(ZO + (size_t)(base + r) * OD_INP + 2048 + 16 * lane + 8 * q); }
#pragma unroll
        for (int r = 0; r < 4; ++r) { float hv[16], ov[16]; { float t8[8]; unpack8(hw[r][0], t8);
#pragma unroll
                for (int q = 0; q < 8; ++q) hv[q] = t8[q]; unpack8(hw[r][1], t8);
#pragma unroll
                for (int q = 0; q < 8; ++q) hv[8 + q] = t8[q]; unpack8(ow[r][0], t8);
#pragma unroll
                for (int q = 0; q < 8; ++q) ov[q] = t8[q]; unpack8(ow[r][1], t8);
#pragma unroll
                for (int q = 0; q < 8; ++q) ov[8 + q] = t8[q]; }
            float ss = 0.f;
#pragma unroll
            for (int q = 0; q < 16; ++q) ss += hv[q] * hv[q];
            ss = row16_sum(ss);
            const float ri = 1.0f / sqrtf(ss * (1.f / 256.f) + RMS_EPS);
            float y0[8], y1[8];
#pragma unroll
            for (int q = 0; q < 8; ++q) { y0[q] = fsigmoid(ov[q]) * (hv[q] * ri * gv[q]); y1[q] = fsigmoid(ov[8 + q]) * (hv[8 + q] * ri * gv[8 + q]); }
            *(u32x4*)(Y + (size_t)(base + r) * D + 16 * lane) = pack8(y0); *(u32x4*)(Y + (size_t)(base + r) * D + 16 * lane + 8) = pack8(y1); }
    }
}

__device__ __forceinline__ void router_phase(const Ctx& X, const bf16* xb, const unsigned char* xr8, const float* wr  , const float* brt, int* topi, float* topw, int* cnt) {
    LAS float* LG = (LAS float*)X.lds + X.wave * (32 * 33);
    LAS int* hist = (LAS int*)(X.lds + 65536);
    const int lane = X.lane, tl = lane & 31, hh = lane >> 5;
    for (int tile = X.bid; tile < T / 256; tile += X.G) {
        if (X.tid < 32) hist[X.tid] = 0;
        __syncthreads();
        const int token = tile * 256 + X.wave * 32 + tl;
        const GAS bf16* xr = (const GAS bf16*)(xb + (size_t)token * D + 512 * hh); const GAS unsigned char* xq = (const GAS unsigned char*)(xr8 + (size_t)token * D + 512 * hh); const GAS float* wp = (const GAS float*)(wr + (size_t)tl * 1024 + 512 * hh);
        f32x16 acc;
#pragma unroll
        for (int r = 0; r < 16; ++r) acc[r] = 0.f;
        u32x4 xa[3], xc[3]; f32x4 wa[4], wc_[4];
#define RT_LOAD(xd, wd, o_) do { xd[0] = *(const GAS u32x4*)(xr + (o_)); xd[1] = *(const GAS u32x4*)(xr + (o_) + 8); xd[2] = *(const GAS u32x4*)(xq + (o_)); \
            _Pragma("unroll") for (int q = 0; q < 4; ++q) wd[q] = *(const GAS f32x4*)(wp + (o_) + 4 * q); } while (0)
#define RT_MMA(xd, wd) do { _Pragma("unroll") for (int q = 0; q < 4; ++q) { const unsigned b0 = xd[q >> 1][(q & 1) * 2], b1 = xd[q >> 1][(q & 1) * 2 + 1], r8 = xd[2][q]; \
            const float x0 = bf_lo(b0) + __builtin_amdgcn_cvt_f32_fp8(r8, 0) * XR_INV, x1 = bf_hi(b0) + __builtin_amdgcn_cvt_f32_fp8(r8, 1) * XR_INV, x2 = bf_lo(b1) + __builtin_amdgcn_cvt_f32_fp8(r8, 2) * XR_INV, x3 = bf_hi(b1) + __builtin_amdgcn_cvt_f32_fp8(r8, 3) * XR_INV; \
            acc = __builtin_amdgcn_mfma_f32_32x32x2f32(x0, wd[q][0], acc, 0, 0, 0); acc = __builtin_amdgcn_mfma_f32_32x32x2f32(x1, wd[q][1], acc, 0, 0, 0); \
            acc = __builtin_amdgcn_mfma_f32_32x32x2f32(x2, wd[q][2], acc, 0, 0, 0); acc = __builtin_amdgcn_mfma_f32_32x32x2f32(x3, wd[q][3], acc, 0, 0, 0); } } while (0)
        RT_LOAD(xa, wa, 0);
        __builtin_amdgcn_sched_barrier(0);
#pragma unroll 1
        for (int bt = 0; bt < 32; bt += 2) {
            RT_LOAD(xc, wc_, 16 * (bt + 1));
            __builtin_amdgcn_sched_barrier(0);
            RT_MMA(xa, wa);
            __builtin_amdgcn_sched_barrier(0);
            { const int o2 = (bt + 2 < 32) ? 16 * (bt + 2) : 0; RT_LOAD(xa, wa, o2); }
            __builtin_amdgcn_sched_barrier(0);
            RT_MMA(xc, wc_);
            __builtin_amdgcn_sched_barrier(0);
        }
#undef RT_LOAD
#undef RT_MMA
        const float bias = brt[tl];
#pragma unroll
        for (int r = 0; r < 16; ++r) { const int trow = (r & 3) + 8 * (r >> 2) + 4 * hh; LG[trow * 33 + tl] = acc[r] + bias; }
        LDS_WAIT();
        if (lane < 32) { float v[32];
#pragma unroll
            for (int e = 0; e < 32; ++e) v[e] = LG[lane * 33 + e];
            float tv[4]; int ti[4];
#pragma unroll
            for (int p = 0; p < 4; ++p) { float best = -3.0e38f; int bi = 0;
#pragma unroll
                for (int e = 0; e < 32; ++e) { if (v[e] > best) { best = v[e]; bi = e; } }
#pragma unroll
                for (int e = 0; e < 32; ++e) { if (e == bi) v[e] = -3.0e38f; }
                tv[p] = best; ti[p] = bi; }
            const float e1 = __expf(tv[1] - tv[0]), e2 = __expf(tv[2] - tv[0]), e3 = __expf(tv[3] - tv[0]); const float inv = 1.0f / (1.0f + e1 + e2 + e3);
            const float ws[4] = {inv, e1 * inv, e2 * inv, e3 * inv};
#pragma unroll
            for (int p = 0; p < 4; ++p) { const int rank = __hip_atomic_fetch_add(&hist[ti[p]], 1, __ATOMIC_RELAXED, __HIP_MEMORY_SCOPE_WORKGROUP); topi[(size_t)token * 4 + p] = ti[p] | (rank << 8); topw[(size_t)token * 4 + p] = ws[p]; } }
        __syncthreads();
        if (X.tid < 32) __hip_atomic_store(cnt + tile * 32 + X.tid, hist[X.tid], RLX_AGENT);
        __syncthreads();
    }
}

__device__ __forceinline__ void dispatch_phase(const Ctx& X, const int* cnt, const int* topi, int* posmap, int* tile_e  , int* rowtok  , unsigned char* zrow  ) {
    LAS int* s_tot = (LAS int*)X.lds; LAS int* s_seg = s_tot + 32; LAS int* s_mine = s_tot + 96; LAS int* s_pos = s_tot + 128;
    const int tid = X.tid, lane = X.lane;
    LAS int* s_cnt = (LAS int*)(X.lds + 16384);
    __syncthreads();
    for (int i = tid; i < 8192; i += 512) s_cnt[i] = __hip_atomic_load(cnt + i, RLX_AGENT);
    __syncthreads();
    if (tid < 32) { int tot = 0; for (int wg = 0; wg < 256; ++wg) tot += s_cnt[wg * 32 + tid]; s_tot[tid] = tot; }
    __syncthreads();
    if (tid == 0) { int seg = 0; for (int e = 0; e < 32; ++e) { s_seg[e] = seg; seg += (s_tot[e] + 255) & ~255; } s_seg[32] = seg; }
    __syncthreads();
    if (X.bid == 0) { const int nmt = s_seg[32] >> 8;
        for (int mt = tid; mt < nmt; mt += 512) { int e = 0; for (int q = 0; q < 32; ++q) if (s_seg[q] <= mt * 256) e = q; __hip_atomic_store(tile_e + mt, e, RLX_AGENT); }
        if (tid == 0) __hip_atomic_store(tile_e + MAXMT, nmt, RLX_AGENT); }
    if (X.bid == X.G - 1 && tid < 64) *(u32x4*)(zrow + 16 * tid) = (u32x4){0u, 0u, 0u, 0u};
    for (int e = X.bid; e < 32; e += X.G) {
        const int r0 = s_seg[e] + s_tot[e], r1 = s_seg[e + 1];
        for (int i = r0 + tid; i < r1; i += 512) rowtok[i] = T; }
    for (int tile = X.bid; tile < T / 256; tile += X.G) {
        __syncthreads();
        if (tid < 32) { int mine = 0; for (int wg = 0; wg < tile; ++wg) mine += s_cnt[wg * 32 + tid]; s_mine[tid] = mine; }
        __syncthreads();
        for (int idx = tid; idx < 1024; idx += 512) { const int pk = topi[(size_t)tile * 1024 + idx], e = pk & 255, rank = pk >> 8; const int pos = s_seg[e] + s_mine[e] + rank; posmap[(size_t)tile * 1024 + idx] = pos; rowtok[pos] = tile * 256 + (idx >> 2); }
    }
    __syncthreads();
}

struct Args { const float* in[28]; float* out; unsigned char* ws; int lo, hi; };
enum { I_X = 0, I_MEM, I_EV_WIN, I_EV_CA, I_EV_CB, I_EV_CBB, I_EV_WR, I_EV_BR, I_EV_WI, I_EV_BI, I_EV_LAM, I_EV_WOUT, I_OD_WIN, I_OD_BG, I_OD_NG, I_OD_WOUT,
       I_WQ, I_WK, I_WV, I_WO, I_WRT, I_BRT, I_W1, I_B1, I_W2, I_B2, I_LNG, I_LNB };

template <int IDX> __device__ __forceinline__ const float* karg() {
    auto ka = __builtin_amdgcn_kernarg_segment_ptr();
    unsigned long long v; asm volatile("s_load_dwordx2 %0, %1, %2\n\ts_waitcnt lgkmcnt(0)" : "=s"(v) : "s"(ka), "n"(IDX * 8)); return (const float*)v; }
#define KIN(i) karg<i>()

#ifndef PH_MASK
#define PH_MASK 0xffffffffu
#endif
#ifndef REP_MASK
#define REP_MASK 0u
#endif
#define PH_BEGIN(g, kind) if (((PH_MASK >> (kind)) & 1u) && lo <= (g) && (g) < hi) { for (int rep_ = 0; rep_ <= (int)((REP_MASK >> (kind)) & 1u); ++rep_) { Ctx X = X0; X.lane = lane_id_opaque(); X.tid = X.wave * 64 + X.lane; unsigned char* ws = ws0; asm volatile("" : "+s"(ws));
#define PH_END(g) } if ((g) + 1 < hi) xcd_barrier(bar); }

#define XB ((bf16*)(ws + WS_XB))
#define MIX ((bf16*)(ws + WS_MIX))
#define MEMB ((bf16*)(ws + WS_MEMB))
#define KM ((bf16*)(ws + WS_KM))
#define VTm ((bf16*)(ws + WS_VT))
#define XF (out_f32)
#define K2 ((float*)(ws + WS_K2))


template <int LAYER>
__device__ __forceinline__ void layer_body(const Ctx& X0, unsigned char* ws0, float* out_f32, const XcdBarrier& bar, const int lo, const int hi) {
    constexpr int layer = LAYER;
    unsigned char* ws = ws0;
        const int gb = 3 + layer * 16, jl = layer >> 1;
        if ((layer & 1) == 0) {
            bf16* Z = (bf16*)(ws + R_Z); bf16* Y = (bf16*)(ws + WS_Y);
            PH_BEGIN(gb + 0, 2)
                pg8::Gemm g{1024, 1024, 1024};
                pg8::DenseOrder S{(const char*)XB, (const char*)(ws + W_EVIN) + (size_t)jl * EV_IN * 1024 * 2, (size_t)256 * 1024 * 2, (size_t)256 * 1024 * 2, 256, EV_IN / 256, X.G, X.bid};
                pg8::EpiStore E{Z, EV_IN, 0, nullptr, 0, 1.0f, 0};
                pg8::gemm_phase(X.lds, g, S, E, X.wave);
            PH_END(gb + 0)
            PH_BEGIN(gb + 1, 3)
                ya_phase(X, Z, KIN(I_EV_CA) + (size_t)jl * 3 * 512, Y);
                lru_phase(X, Z, (const bf16*)(ws + W_GATE) + (size_t)jl * 8 * 256 * 128, KIN(I_EV_CB) + (size_t)jl * 4 * 1024, KIN(I_EV_CBB) + (size_t)jl * 1024,
                          KIN(I_EV_BR) + (size_t)jl * 1024, KIN(I_EV_BI) + (size_t)jl * 1024, K2 + (size_t)jl * 1024, Y);
            PH_END(gb + 1)
            PH_BEGIN(gb + 4, 6)
                pg8::Gemm g{EV_Y, EV_Y, EV_Y};
                pg8::DenseOrder S{(const char*)Y, (const char*)(ws + W_EVOUT) + (size_t)jl * 1024 * EV_Y * 2, (size_t)256 * EV_Y * 2, (size_t)256 * EV_Y * 2, 256, 4, X.G, X.bid};
                pg8::EpiStore E{MIX, 1024, 0, nullptr, 0, 1.0f, 0};
                pg8::gemm_phase(X.lds, g, S, E, X.wave);
            PH_END(gb + 4)
        } else {
            bf16* ZO = (bf16*)(ws + R_Z); bf16* HB = (bf16*)(ws + R_HB); bf16* Y = (bf16*)(ws + WS_Y); float* GATES = (float*)(ws + WS_GATES);
            PH_BEGIN(gb + 0, 7)
                gates_phase(X, XB, ws + WS_XR8, KIN(I_OD_WIN) + (size_t)jl * 1024 * OD_IN, KIN(I_OD_BG) + (size_t)jl * 8, GATES);
                pg8::Gemm g{1024, 1024, 1024};
                pg8::DenseOrder S{(const char*)XB, (const char*)(ws + W_ODIN) + (size_t)jl * OD_INP * 1024 * 2, (size_t)256 * 1024 * 2, (size_t)256 * 1024 * 2, 256, OD_INP / 256, X.G, X.bid};
                pg8::EpiStore E{ZO, OD_INP, 0, nullptr, 0, 0.08838834764831845f, 2};
                pg8::gemm_phase(X.lds, g, S, E, X.wave);
            PH_END(gb + 0)
            PH_BEGIN(gb + 1, 8)
                mlstm_phase(X, ZO, GATES, HB);
            PH_END(gb + 1)
            PH_BEGIN(gb + 2, 9)
                hnorm_phase(X, HB, ZO, KIN(I_OD_NG) + (size_t)jl * 1024, Y);
            PH_END(gb + 2)
            PH_BEGIN(gb + 4, 10)
                pg8::Gemm g{1024, 1024, 1024};
                pg8::DenseOrder S{(const char*)Y, (const char*)(ws + W_ODOUT) + (size_t)jl * 1024 * 1024 * 2, (size_t)256 * 1024 * 2, (size_t)256 * 1024 * 2, 256, 4, X.G, X.bid};
                pg8::EpiStore E{MIX, 1024, 0, nullptr, 0, 1.0f, 0};
                pg8::gemm_phase(X.lds, g, S, E, X.wave);
            PH_END(gb + 4)
        }
        PH_BEGIN(gb + 5, 11)
            ln_phase<false, 4>(X, layer == 0 ? KIN(I_X) : nullptr, MIX, nullptr, nullptr, KIN(I_LNG) + (size_t)layer * 3 * D, KIN(I_LNB) + (size_t)layer * 3 * D, nullptr, XB, ws + WS_XR8, ws + R_XA8);
        PH_END(gb + 5)
        {
            bf16* Q = (bf16*)(ws + R_Q); bf16* P = (bf16*)(ws + R_P); bf16* O = (bf16*)(ws + R_O);
            PH_BEGIN(gb + 6, 12)
                pg8::Gemm g{512, 512, 512};
                pg8::BatchOrder S{(const char*)(ws + R_XA8), (const char*)(ws + WS_M1) + (size_t)layer * 16 * 1024 * 1024, (size_t)256 * 1024, (size_t)0, (size_t)1024 * 1024, (size_t)256 * 1024, 4, 256, 4, X.G, X.bid};
                pg8::EpiSoftmax E{(unsigned char*)P, 0.0625f / M1_SCALE};
                pg8::gemm_phase<pg8::EpiSoftmax, pg8::BatchOrder, true>(X.lds, g, S, E, X.wave);
            PH_END(gb + 6)
            PH_BEGIN(gb + 9, 15)
                pg8::Gemm g{512, 512, 512};
                pg8::BatchOrder S{(const char*)P, (const char*)(ws + WS_M2) + (size_t)layer * 16 * 1024 * 1024, (size_t)256 * 1024, (size_t)0, (size_t)1024 * 1024, (size_t)256 * 1024, 4, 256, 4, X.G, X.bid};
                pg8::EpiStore E{MIX, 1024, 0, nullptr, 0, 1.0f, 0, 1.0f / (256.0f * M2_SCALE)};
                pg8::gemm_phase<pg8::EpiStore, pg8::BatchOrder, true>(X.lds, g, S, E, X.wave);
            PH_END(gb + 9)
        }
        PH_BEGIN(gb + 10, 16)
            ln_phase<false, 4>(X, nullptr, MIX, nullptr, nullptr, KIN(I_LNG) + (size_t)layer * 3 * D + D, KIN(I_LNB) + (size_t)layer * 3 * D + D, nullptr, XB, ws + WS_XR8, ws + R_XG);
        PH_END(gb + 10)
        {
            int* topi = (int*)(ws + WS_TOPI); float* topw = (float*)(ws + WS_TOPW); int* posmap = (int*)(ws + WS_POSMAP);
            int* cnt = (int*)(ws + WS_CNT) + (size_t)layer * 8192; int* tile_e = (int*)(ws + WS_TILEE) + (size_t)layer * 2048;
            unsigned char* XG = ws + R_XG; unsigned char* HID = ws + R_HID; bf16* EO = (bf16*)(ws + R_EO);
            PH_BEGIN(gb + 11, 17)
                router_phase(X, XB, ws + WS_XR8, (const float*)(ws + WS_WRT) + (size_t)layer * 32 * 1024, KIN(I_BRT) + (size_t)layer * 32, topi, topw, cnt);
            PH_END(gb + 11)
            PH_BEGIN(gb + 12, 18)
                dispatch_phase(X, cnt, topi, posmap, tile_e, (int*)(ws + WS_ROWTOK), XG + (size_t)T * D);
            PH_END(gb + 12)
            PH_BEGIN(gb + 13, 19)
                const int nmt = __builtin_amdgcn_readfirstlane(__hip_atomic_load(tile_e + MAXMT, RLX_AGENT));
                pg8::Gemm g{512, 512, 512, (const int*)(ws + WS_ROWTOK)};
                LAS int* te = (LAS int*)(X.lds + XCH_OFF); for (int i = X.tid; i < nmt; i += 512) te[i] = __hip_atomic_load(tile_e + i, RLX_AGENT); __syncthreads();
                pg8::MoeOrder S{(const char*)XG, (const char*)(ws + W_1) + (size_t)layer * 32 * 2048 * 1024, (size_t)0, (size_t)2048 * 1024, (size_t)256 * 1024, te, nmt, 8, X.G, X.bid};
                pg8::EpiSwiglu E{HID, KIN(I_B1) + (size_t)layer * 32 * 2048, 1.0f / W1_SCALE};
                pg8::gemm_phase<pg8::EpiSwiglu, pg8::MoeOrder, true, true>(X.lds, g, S, E, X.wave);
            PH_END(gb + 13)
            PH_BEGIN(gb + 14, 20)
                const int nmt = __builtin_amdgcn_readfirstlane(__hip_atomic_load(tile_e + MAXMT, RLX_AGENT));
                pg8::Gemm g{512, 512, 512};
                LAS int* te = (LAS int*)(X.lds + XCH_OFF); for (int i = X.tid; i < nmt; i += 512) te[i] = __hip_atomic_load(tile_e + i, RLX_AGENT); __syncthreads();
                pg8::MoeOrder S{(const char*)HID, (const char*)(ws + W_2) + (size_t)layer * 32 * 1024 * 1024, (size_t)256 * 1024, (size_t)1024 * 1024, (size_t)256 * 1024, te, nmt, 4, X.G, X.bid};
                pg8::EpiStore8T<true> E{(unsigned char*)EO, 1024, EO_SCALE, KIN(I_B2) + (size_t)layer * 32 * 1024, 1024, 1.0f / W2_SCALE};
                pg8::gemm_phase<pg8::EpiStore8T<true>, pg8::MoeOrder, true>(X.lds, g, S, E, X.wave);
            PH_END(gb + 14)
            PH_BEGIN(gb + 15, 21)
                ln_phase<true, 2>(X, nullptr, EO, posmap, topw, KIN(I_LNG) + (size_t)layer * 3 * D + 2 * D, KIN(I_LNB) + (size_t)layer * 3 * D + 2 * D, layer == DEPTH - 1 ? XF : nullptr, XB, ws + WS_XR8);
            PH_END(gb + 15)
        }
    }

__global__ void __launch_bounds__(512, 2) mk_fwd(Args args) {
    extern __shared__ __attribute__((aligned(16))) unsigned char lds_raw[];
    Ctx X0; X0.lds = (LAS unsigned char*)lds_raw; X0.tid = threadIdx.x; X0.lane = X0.tid & 63; X0.wave = __builtin_amdgcn_readfirstlane(X0.tid >> 6);     X0.bid = blockIdx.x; X0.G = gridDim.x;
    unsigned char* ws0 = args.ws;
    unsigned char* ws = ws0;
    volatile LAS unsigned* MISC = (volatile LAS unsigned*)(X0.lds + MISC_OFF);
    if (X0.tid < 64) MISC[X0.tid] = 0u;
    __syncthreads();
    XcdBarrier bar; bar.bar = (unsigned*)(ws + WS_CTL) + CW_BAR; bar.x = 0; bar.st = MISC; bar.wave = X0.wave;
    if (args.hi - args.lo > 1) bar = xcd_barrier_post((unsigned*)(ws + WS_CTL) + CW_BAR, MISC, X0.wave);
    const int lo = args.lo, hi = args.hi;
    PH_BEGIN(0, 0)
        conv_group(X, KIN(I_EV_WIN), 2, 1024, EV_IN, EV_IN, (size_t)1024 * EV_IN, (bf16*)(ws + W_EVIN), (size_t)EV_IN * 1024, 0);
        conv_group(X, KIN(I_EV_WOUT), 2, EV_Y, 1024, 1024, (size_t)EV_Y * 1024, (bf16*)(ws + W_EVOUT), (size_t)1024 * EV_Y, 0);
        conv_group(X, KIN(I_EV_WR), 16, 128, 128, 128, (size_t)128 * 128, (bf16*)(ws + W_GATE), (size_t)256 * 128, 0);
        conv_group(X, KIN(I_EV_WI), 16, 128, 128, 128, (size_t)128 * 128, (bf16*)(ws + W_GATE) + 128 * 128, (size_t)256 * 128, 0);
        conv_group(X, KIN(I_OD_WIN), 2, 1024, OD_INP, OD_IN, (size_t)1024 * OD_IN, (bf16*)(ws + W_ODIN), (size_t)OD_INP * 1024, 0);
        conv_group(X, KIN(I_OD_WOUT), 2, 1024, 1024, 1024, (size_t)1024 * 1024, (bf16*)(ws + W_ODOUT), (size_t)1024 * 1024, 0);
        cvt_flat8(X, KIN(I_WQ), ws + W_Q, (size_t)4 * 1024 * 1024, WQ_SCALE);
        conv_group(X, KIN(I_WK), 4, 1024, 1024, 1024, (size_t)1024 * 1024, (bf16*)(ws + W_K), (size_t)1024 * 1024, 0, WQ_SCALE);
        conv_group(X, KIN(I_WV), 4, 1024, 1024, 1024, (size_t)1024 * 1024, (bf16*)(ws + W_V), (size_t)1024 * 1024, 0, WQ_SCALE);
        conv_group(X, KIN(I_WO), 4, 1024, 1024, 1024, (size_t)1024 * 1024, (bf16*)(ws + W_O), (size_t)1024 * 1024, 0, WO_SCALE);
        conv_group(X, KIN(I_W1), 128, 1024, 2048, 2048, (size_t)1024 * 2048, (bf16*)(ws + W_1), (size_t)2048 * 1024, 1, W1_SCALE);
        conv_group(X, KIN(I_W2), 128, 1024, 1024, 1024, (size_t)1024 * 1024, (bf16*)(ws + W_2), (size_t)1024 * 1024, 0, W2_SCALE);
        cvt_flat(X, KIN(I_X), XB, (size_t)T * D);
        cvt_flat8(X, KIN(I_MEM), (unsigned char*)MEMB, (size_t)NBATCH * NMEM * D);
        for (int i = X.bid * 512 + X.tid; i < 4 * 32 * 1024; i += X.G * 512) { const int l = i >> 15, e = (i >> 10) & 31, k = i & 1023; ((float*)(ws + WS_WRT))[i] = KIN(I_WRT)[(size_t)l * 32768 + k * 32 + e]; }
        for (int i = X.bid * 512 + X.tid; i < 2048; i += X.G * 512) { const float lam = KIN(I_EV_LAM)[i]; const float sp = fmaxf(-lam, 0.f) + log1pf(__expf(-fabsf(lam)));
            K2[i] = -8.0f * sp * 1.4426950408889634f; }
        __syncthreads();
    PH_END(0)

    PH_BEGIN(1, 1)
        { pg8::Gemm g{512, 512, 512};
          pg8::StackOrder S{(const char*)MEMB, (const char*)(ws + W_K), (size_t)256 * 1024, (size_t)256 * 1024, 0, (size_t)1024 * 1024, 16, 4, 4, X.G, X.bid};
          pg8::EpiStore8 E{(unsigned char*)KM, 1024, 1.0f / WQ_SCALE, nullptr, 0, 1.0f, (size_t)4096 * 1024};
          pg8::gemm_phase<pg8::EpiStore8, pg8::StackOrder, true>(X.lds, g, S, E, X.wave); }
        { pg8::Gemm g{512, 512, 512};
          pg8::StackOrder S{(const char*)MEMB, (const char*)(ws + W_V), (size_t)256 * 1024, (size_t)256 * 1024, 0, (size_t)1024 * 1024, 16, 4, 4, X.G, X.bid};
          pg8::EpiStore8 E{(unsigned char*)VTm, 1024, 1.0f / WQ_SCALE, nullptr, 0, 1.0f, (size_t)4096 * 1024};
          pg8::gemm_phase<pg8::EpiStore8, pg8::StackOrder, true>(X.lds, g, S, E, X.wave); }
    PH_END(1)

    PH_BEGIN(2, 22)
        { pg8::Gemm g{512, 512, 128};
          pg8::FoldOrder S{(const char*)KM, (const char*)(ws + W_Q), false, X.G, X.bid};
          pg8::EpiStore8 E{ws + WS_M1, 1024, M1_SCALE / WQ_SCALE, nullptr, 0, 1.0f, (size_t)256 * 1024};
          pg8::gemm_phase<pg8::EpiStore8, pg8::FoldOrder, true>(X.lds, g, S, E, X.wave); }
        { pg8::Gemm g{512, 512, 128};
          pg8::FoldOrder S{(const char*)(ws + W_O), (const char*)VTm, true, X.G, X.bid};
          pg8::EpiStore8 E{ws + WS_M2, 1024, M2_SCALE / WO_SCALE, nullptr, 0, 1.0f, (size_t)1024 * 1024};
          pg8::gemm_phase<pg8::EpiStore8, pg8::FoldOrder, true>(X.lds, g, S, E, X.wave); }
    PH_END(2)

    layer_body<0>(X0, ws0, args.out, bar, lo, hi); layer_body<1>(X0, ws0, args.out, bar, lo, hi); layer_body<2>(X0, ws0, args.out, bar, lo, hi); layer_body<3>(X0, ws0, args.out, bar, lo, hi);
#undef PH_BEGIN
#undef PH_END
}

extern "C" void kernel_launch(void* const* d_in, const int* in_sizes, int n_in, void* d_out, int out_size, void* d_ws, size_t ws_size, hipStream_t stream) {
    static int grid = 0;
    if (grid == 0) {
        if (n_in != 28 || in_sizes[0] != T * D || out_size != T * D || ws_size < WS_END) { fprintf(stderr, "kernel_launch: unexpected shapes (n_in %d, in0 %d, out %d, ws %zu, need %zu); nothing launched\n", n_in, n_in > 0 ? in_sizes[0] : -1, out_size, ws_size, (size_t)WS_END); grid = -1; return; }
        int dev = 0, cus = 0, per_cu = 0;
        if (hipGetDevice(&dev) != hipSuccess || hipDeviceGetAttribute(&cus, hipDeviceAttributeMultiprocessorCount, dev) != hipSuccess) { grid = -1; return; }
        if (hipFuncSetAttribute((const void*)mk_fwd, hipFuncAttributeMaxDynamicSharedMemorySize, LDS_BYTES) != hipSuccess) { fprintf(stderr, "kernel_launch: hipFuncSetAttribute failed\n"); grid = -1; return; }
        if (hipOccupancyMaxActiveBlocksPerMultiprocessor(&per_cu, (const void*)mk_fwd, 512, LDS_BYTES) != hipSuccess || per_cu < 1) { fprintf(stderr, "kernel_launch: occupancy query reports %d\n", per_cu); }
        (void)hipGetLastError();
        grid = cus;
    }
    if (grid < 0) return;
    if (hipMemsetAsync((char*)d_ws + WS_CTL, 0, CTL_ZERO_BYTES, stream) != hipSuccess) return;
    Args a{};
    for (int i = 0; i < 28; ++i) a.in[i] = (const float*)d_in[i];
    a.out = (float*)d_out; a.ws = (unsigned char*)d_ws;
#if MK_N_LAUNCHES == 1
    a.lo = 0; a.hi = 3 + DEPTH * 16;
    hipLaunchKernelGGL(mk_fwd, dim3(grid), dim3(512), LDS_BYTES, stream, a);
#else
    for (int g = 0; g < 3 + DEPTH * 16; ++g) {
        if (g >= 3) { const int layer = (g - 3) / 16, k = (g - 3) % 16; if (k == 7 || k == 8) continue; if ((layer & 1) && k == 3) continue; if (!(layer & 1) && (k == 2 || k == 3)) continue; }
        a.lo = g; a.hi = g + 1;
        hipLaunchKernelGGL(mk_fwd, dim3(grid), dim3(512), LDS_BYTES, stream, a);
    }
#endif
}
```

```cpp
#include <hip/hip_runtime.h>
#include <cstdio>
#include <cstdint>

#ifndef MK_N_LAUNCHES
#define MK_N_LAUNCHES 1
#endif

#define GAS __attribute__((address_space(1)))
#define LAS __attribute__((address_space(3)))
typedef unsigned short bf16;
typedef short bf16x8 __attribute__((ext_vector_type(8)));
typedef short bf16x4 __attribute__((ext_vector_type(4)));
typedef float f32x2 __attribute__((ext_vector_type(2)));
typedef float f32x4 __attribute__((ext_vector_type(4)));
typedef float f32x16 __attribute__((ext_vector_type(16)));
typedef unsigned u32x2 __attribute__((ext_vector_type(2)));
typedef unsigned u32x4 __attribute__((ext_vector_type(4)));
typedef int i32x4 __attribute__((ext_vector_type(4)));
typedef int i32x8 __attribute__((ext_vector_type(8)));
typedef GAS unsigned gu32;
#define RLX_AGENT __ATOMIC_RELAXED, __HIP_MEMORY_SCOPE_AGENT
#define LDS_WAIT() asm volatile("s_waitcnt lgkmcnt(0)" ::: "memory")
#define VM_WAIT() asm volatile("s_waitcnt vmcnt(0)" ::: "memory")
#define WG_BAR() do { asm volatile("s_waitcnt lgkmcnt(0)" ::: "memory"); __builtin_amdgcn_s_barrier(); asm volatile("" ::: "memory"); } while (0)

constexpr int T = 65536, D = 1024, SEQ = 4096, NBATCH = 16, NMEM = 256, DEPTH = 4;
constexpr int EV_IN = 3584, OD_IN = 3080, OD_INP = 3072, EV_Y = 1536;
constexpr int NEXP = 32, DFF = 1024;
constexpr float DN_ALPHA = 1.6817928305074290f;
constexpr float LN_EPS = 1e-5f, RMS_EPS = 1e-6f;
constexpr float XR_SCALE = 4096.0f, XR_INV = 1.0f / 4096.0f;
constexpr float W1_SCALE = 64.0f, W2_SCALE = 128.0f, WQ_SCALE = 64.0f, WO_SCALE = 128.0f, O8_SCALE = 8.0f, EO_SCALE = 4.0f, M1_SCALE = 2.0f, M2_SCALE = 4.0f;
constexpr int MAXMT = 1056;

__device__ __forceinline__ unsigned cvt_pk_bf16(float lo, float hi) { unsigned r; asm("v_cvt_pk_bf16_f32 %0, %1, %2" : "=v"(r) : "v"(lo), "v"(hi)); return r; }
__device__ __forceinline__ unsigned cvt_pk4_fp8(float a, float b, float c, float d) { int p = __builtin_amdgcn_cvt_pk_fp8_f32(a, b, 0, false); p = __builtin_amdgcn_cvt_pk_fp8_f32(c, d, p, true); return (unsigned)p; }
__device__ __forceinline__ float bf_lo(unsigned w) { return __uint_as_float(w << 16); }
__device__ __forceinline__ float bf_hi(unsigned w) { return __uint_as_float(w & 0xffff0000u); }
__device__ __forceinline__ float bf1(bf16 v) { return __uint_as_float(((unsigned)v) << 16); }
__device__ __forceinline__ float fsigmoid(float x) { return __builtin_amdgcn_rcpf(1.0f + __expf(-x)); }
#define DPP_F(v, ctrl) __builtin_bit_cast(float, __builtin_amdgcn_update_dpp(0, __builtin_bit_cast(int, (v)), (ctrl), 0xf, 0xf, true))
__device__ __forceinline__ float row16_sum(float v) { v += DPP_F(v, 0xB1); v += DPP_F(v, 0x4E); v += DPP_F(v, 0x141); v += DPP_F(v, 0x140); return v; }
__device__ __forceinline__ float rdlane(float v, int l) { return __builtin_bit_cast(float, __builtin_amdgcn_readlane(__builtin_bit_cast(int, v), l)); }
__device__ __forceinline__ float wave_sum(float v) { v = row16_sum(v); return (rdlane(v, 0) + rdlane(v, 16)) + (rdlane(v, 32) + rdlane(v, 48)); }

__device__ __forceinline__ int lane_id_opaque() { int l; asm volatile("v_mbcnt_lo_u32_b32 %0, -1, 0\n\tv_mbcnt_hi_u32_b32 %0, -1, %0" : "=v"(l)); return l; }
namespace pg8 {
constexpr int BM = 256, BK = 64, HALF = 128, HTB = HALF * BK * 2, STAGE_BYTES = 8 * HTB, NXCD = 8, WGM = 8;
__host__ __device__ __forceinline__ int lds_byte(int r, int c) { const int st = (r >> 4) * 2 + (c >> 5), rr = r & 15, cc = c & 31, ob = rr * 64 + cc * 2; return st * 1024 + (ob ^ (((ob >> 9) & 1) << 5)); }
__host__ __device__ __forceinline__ void stage_rc(int b, int& R, int& C) { const int st = b / 1024, sb = b % 1024, swz = sb ^ (((sb >> 9) & 1) << 5); R = (st >> 1) * 16 + swz / 64; C = (st & 1) * 32 + (swz % 64) / 2; }
__host__ __device__ __forceinline__ int perm32(int rho) { const int n = rho >> 4, i = rho & 15; return 8 * (i >> 2) + 4 * n + (i & 3); }

struct Unit { const char* a; const char* b; int pm, pn, z; };
struct Gemm { int lda, ldb, K; const int* gidx = nullptr; };

__device__ __forceinline__ bool static_map(long L, int nM, int nN, int& pm, int& pn) {
    const int nwg = nM * nN; if (L >= nwg) return false;
    int wgid = (int)L; { const int q = nwg / NXCD, r = nwg % NXCD, xcd = wgid % NXCD, off = wgid / NXCD; wgid = (xcd < r ? xcd * (q + 1) : r * (q + 1) + (xcd - r) * q) + off; }
    const int nig = WGM * nN, gid = wgid / nig, fm = gid * WGM, gsz = (nM - fm) < WGM ? (nM - fm) : WGM;
    pm = fm + ((wgid % nig) % gsz); pn = (wgid % nig) / gsz; return true;
}

template <class Epi, class Sched, bool F8 = false, bool GA = false>
__device__ __forceinline__ void gemm_phase(LAS unsigned char* lds, const Gemm g, const Sched& S, const Epi& E, int wave) {
    const int lane = lane_id_opaque(), wid = wave, tid = wid * 64 + lane,
              wr = wid >> 2, wc = wid & 3, fr = lane & 15, fq = lane >> 4;
    int K_ = g.K; asm volatile("" : "+s"(K_));
    const int K = K_, nt = K / BK;
    unsigned voffA[2], voffB[2]; int RA[2]; unsigned CB[2];
#pragma unroll
    for (int i = 0; i < 2; ++i) { int R, C; stage_rc(tid * 16 + i * 8192, R, C); const int Rb = Epi::PERM ? ((R & ~31) + perm32(R & 31)) : R;
        voffA[i] = (unsigned)(R * g.lda + C) * 2u; voffB[i] = (unsigned)(Rb * g.ldb + C) * 2u; RA[i] = R; CB[i] = (unsigned)C * 2u; }
    const unsigned rowb = (unsigned)g.lda * 2u;
    unsigned vG[2][2], vGN[2][2];
    LAS unsigned char* const gslot = lds + STAGE_BYTES + 8192;
    const size_t kstep = (size_t)(BK * 2);
    const size_t hstepA = (size_t)HALF * g.lda * 2, hstepB = (size_t)HALF * g.ldb * 2;
    const unsigned ldsw = (unsigned)wid * 1024u;
    const int aoff = lds_byte(wr * 64 + fr, fq * 8), boff = lds_byte(wc * 32 + fr, fq * 8);
#define PG8_SA(b, h) (((b) * 2 + (h)) * HTB)
#define PG8_SB(b, h) ((4 + (b) * 2 + (h)) * HTB)
#define PG8_STAGE(bufoff, gbase, voff) do { _Pragma("unroll") for (int _i = 0; _i < 2; ++_i) \
        __builtin_amdgcn_global_load_lds((const unsigned*)((const char*)(gbase) + (voff)[_i]), (LAS unsigned*)(lds + (bufoff) + ldsw + _i * 8192), 16, 0, 0); } while (0)
#define PG8_LDA(dst, b, h) do { _Pragma("unroll") for (int m = 0; m < 4; ++m) _Pragma("unroll") for (int k = 0; k < 2; ++k) dst[m][k] = *(const LAS bf16x8*)(lds + PG8_SA(b, h) + aoff + m * 2048 + k * 1024); } while (0)
#define PG8_LDB(dst, b, h) do { _Pragma("unroll") for (int n = 0; n < 2; ++n) _Pragma("unroll") for (int k = 0; k < 2; ++k) dst[n][k] = *(const LAS bf16x8*)(lds + PG8_SB(b, h) + boff + n * 2048 + k * 1024); } while (0)
#define PG8_CAT(x) __builtin_shufflevector(__builtin_bit_cast(i32x4, (x)[0]), __builtin_bit_cast(i32x4, (x)[1]), 0, 1, 2, 3, 4, 5, 6, 7)
#define PG8_MMA(ai, bj, At, Bt) do { __builtin_amdgcn_s_setprio(1); \
        if constexpr (F8) { _Pragma("unroll") for (int m = 0; m < 4; ++m) _Pragma("unroll") for (int n = 0; n < 2; ++n) \
            asm volatile("v_mfma_scale_f32_16x16x128_f8f6f4 %0, %1, %2, %0, %3, %3 op_sel_hi:[0,0,0]" : "+v"(acc[ai][bj][m][n]) : "v"(PG8_CAT(Bt[n])), "v"(PG8_CAT(At[m])), "v"(f8one)); } \
        else { _Pragma("unroll") for (int m = 0; m < 4; ++m) _Pragma("unroll") for (int n = 0; n < 2; ++n) _Pragma("unroll") for (int k = 0; k < 2; ++k) \
            acc[ai][bj][m][n] = __builtin_amdgcn_mfma_f32_16x16x32_bf16(Bt[n][k], At[m][k], acc[ai][bj][m][n], 0, 0, 0); } \
        __builtin_amdgcn_s_setprio(0); } while (0)
#define PG8_WAIT_V(n) asm volatile("s_waitcnt vmcnt(" #n ")" ::: "memory")
#define PG8_WAIT_L(n) asm volatile("s_waitcnt lgkmcnt(" #n ")" ::: "memory")
#define PG8_BAR __builtin_amdgcn_s_barrier()
#define PG8_SCHED __builtin_amdgcn_sched_barrier(0)
    Unit cur, nxt; int ui = 0;
    if (!S.next(0, cur)) return;
    f32x4 acc[2][2][4][2];
#pragma unroll
    for (int a = 0; a < 2; ++a)
#pragma unroll
        for (int b = 0; b < 2; ++b)
#pragma unroll
            for (int m = 0; m < 4; ++m)
#pragma unroll
                for (int n = 0; n < 2; ++n) acc[a][b][m][n] = (f32x4){0.f, 0.f, 0.f, 0.f};
    bf16x8 At[4][2], B0[2][2], B1[2][2];
    const int f8one = 0x7f7f7f7f;
    const char* cA = cur.a; const char* cB = cur.b;
    if constexpr (Epi::LDSBIAS) E.stage_bias(cur, lds + STAGE_BYTES + 4608, wid, lane);
    if constexpr (GA) {
#pragma unroll
        for (int h = 0; h < 2; ++h)
#pragma unroll
            for (int i = 0; i < 2; ++i) { vG[h][i] = (unsigned)g.gidx[(size_t)cur.pm * 256 + 128 * h + RA[i]] * rowb + CB[i]; vGN[h][i] = vG[h][i]; } }
#define PG8_STAGE_A(bufoff, gbase, h, vg) do { if constexpr (GA) PG8_STAGE(bufoff, gbase, (vg)[h]); else PG8_STAGE(bufoff, (gbase) + (h) * hstepA, voffA); } while (0)
    PG8_STAGE(PG8_SB(0, 0), cB, voffB); PG8_STAGE(PG8_SB(0, 1), cB + hstepB, voffB); PG8_STAGE_A(PG8_SA(0, 0), cA, 0, vG); PG8_STAGE_A(PG8_SA(0, 1), cA, 1, vG);
    if (wr == 1) PG8_BAR;
    PG8_WAIT_V(2); PG8_BAR;
    PG8_STAGE(PG8_SB(1, 0), cB + kstep, voffB); PG8_STAGE_A(PG8_SA(1, 0), cA + kstep, 0, vG); PG8_STAGE(PG8_SB(1, 1), cB + hstepB + kstep, voffB);
    PG8_WAIT_V(6); PG8_BAR;
    for (;;) {
        const bool has_next = S.next(ui + 1, nxt);
        const char* nA = has_next ? nxt.a : cA; const char* nB = has_next ? nxt.b : cB;
        if constexpr (Epi::LDSBIAS) { if (ui > 0) E.stage_bias(cur, lds + STAGE_BYTES + 4608 + (ui & 1) * 1024, wid, lane); }
        if constexpr (GA) { if (has_next && wid == 1) __builtin_amdgcn_global_load_lds((const unsigned*)(g.gidx + (size_t)nxt.pm * 256 + 4 * lane), (LAS unsigned*)(gslot + ((ui + 1) & 1) * 1024), 16, 0, 0); }
#pragma clang loop unroll(disable)
        for (int t = 0; t < nt; t += 2) {
            const bool last = (t == nt - 2);
            const char* a1 = cA + (size_t)(t + 1) * kstep;
            const char* a2 = last ? nA : cA + (size_t)(t + 2) * kstep; const char* b2 = last ? nB : cB + (size_t)(t + 2) * kstep;
            const char* a3 = a2 + kstep; const char* b3 = b2 + kstep;
            unsigned vS[2][2];
            if constexpr (GA) {
                if (last && has_next) { const LAS int* ix = (const LAS int*)(gslot + ((ui + 1) & 1) * 1024);
#pragma unroll
                    for (int h = 0; h < 2; ++h)
#pragma unroll
                        for (int i = 0; i < 2; ++i) vGN[h][i] = (unsigned)ix[128 * h + RA[i]] * rowb + CB[i]; }
#pragma unroll
                for (int h = 0; h < 2; ++h)
#pragma unroll
                    for (int i = 0; i < 2; ++i) vS[h][i] = last ? vGN[h][i] : vG[h][i]; }
            PG8_LDB(B0, 0, 0); PG8_LDB(B1, 0, 1); PG8_SCHED; PG8_LDA(At, 0, 0); PG8_STAGE_A(PG8_SA(1, 1), a1, 1, vG);
            PG8_WAIT_V(8); PG8_WAIT_L(0); PG8_BAR; PG8_MMA(0, 0, At, B0); PG8_MMA(0, 1, At, B1); PG8_BAR; PG8_SCHED;
            PG8_LDA(At, 0, 1); PG8_STAGE(PG8_SB(0, 0), b2, voffB); PG8_STAGE(PG8_SB(0, 1), b2 + hstepB, voffB); PG8_STAGE_A(PG8_SA(0, 0), a2, 0, vS);
            PG8_WAIT_V(8); PG8_WAIT_L(0); PG8_BAR; PG8_MMA(1, 0, At, B0); PG8_MMA(1, 1, At, B1); PG8_BAR; PG8_SCHED;
            PG8_LDB(B0, 1, 0); PG8_LDB(B1, 1, 1); PG8_SCHED; PG8_LDA(At, 1, 0); PG8_STAGE_A(PG8_SA(0, 1), a2, 1, vS);
            PG8_WAIT_V(8); PG8_WAIT_L(0); PG8_BAR; PG8_MMA(0, 0, At, B0); PG8_MMA(0, 1, At, B1); PG8_BAR; PG8_SCHED;
            PG8_LDA(At, 1, 1); PG8_STAGE(PG8_SB(1, 0), b3, voffB); PG8_STAGE(PG8_SB(1, 1), b3 + hstepB, voffB); PG8_STAGE_A(PG8_SA(1, 0), a3, 0, vS);
            PG8_WAIT_V(8); PG8_WAIT_L(0); PG8_BAR; PG8_MMA(1, 0, At, B0); PG8_MMA(1, 1, At, B1); PG8_BAR; PG8_SCHED;
        }
        if constexpr (F8) asm volatile("s_nop 15\n\ts_nop 15" ::: "memory");
        if (wr == 0) PG8_BAR;
        E(acc, cur, wr, wc, fr, fq, Epi::LDSBIAS ? lds + STAGE_BYTES + 4608 + (ui & 1) * 1024 : lds + STAGE_BYTES);
        if (!has_next) break;
#pragma unroll
        for (int a = 0; a < 2; ++a)
#pragma unroll
            for (int b = 0; b < 2; ++b)
#pragma unroll
                for (int m = 0; m < 4; ++m)
#pragma unroll
                    for (int n = 0; n < 2; ++n) acc[a][b][m][n] = (f32x4){0.f, 0.f, 0.f, 0.f};
        cur = nxt; cA = nA; cB = nB; ++ui;
        if constexpr (GA) {
#pragma unroll
            for (int h = 0; h < 2; ++h)
#pragma unroll
                for (int i = 0; i < 2; ++i) vG[h][i] = vGN[h][i]; }
        if (wr == 1) PG8_BAR;
    }
    PG8_WAIT_V(0);
    PG8_BAR;
#undef PG8_SA
#undef PG8_SB
#undef PG8_STAGE
#undef PG8_STAGE_A
#undef PG8_LDA
#undef PG8_LDB
#undef PG8_MMA
#undef PG8_CAT
#undef PG8_WAIT_V
#undef PG8_WAIT_L
#undef PG8_BAR
#undef PG8_SCHED
}

struct DenseOrder {
    const char* A; const char* B; size_t astep, bstep; int nM, nN, G, c;
    __device__ __forceinline__ bool next(int i, Unit& u) const {
        int pm, pn; if (!static_map((long)i * G + c, nM, nN, pm, pn)) return false;
        u.pm = pm; u.pn = pn; u.z = 0; u.a = A + (size_t)pm * astep; u.b = B + (size_t)pn * bstep; return true; }
};
struct BatchOrder {
    const char* A; const char* B; size_t astep, astep2, bstepm, bstepn; int bshift, nM, nN, G, c;
    __device__ __forceinline__ bool next(int i, Unit& u) const {
        int pm, pn; if (!static_map((long)i * G + c, nM, nN, pm, pn)) return false;
        u.pm = pm; u.pn = pn; u.z = 0; u.a = A + (size_t)pm * astep + (size_t)pn * astep2; u.b = B + (size_t)(pm >> bshift) * bstepm + (size_t)pn * bstepn; return true; }
};
struct StackOrder {
    const char* A; const char* B; size_t astep, bstep, azstep, bzstep; int nM, nN, nZ, G, c;
    __device__ __forceinline__ bool next(int i, Unit& u) const {
        const long L = (long)i * G + c; const int per = nM * nN; if (L >= (long)per * nZ) return false;
        const int z = (int)(L / per); int pm, pn; static_map(L - (long)z * per, nM, nN, pm, pn);
        u.pm = pm; u.pn = pn; u.z = z; u.a = A + (size_t)z * azstep + (size_t)pm * astep; u.b = B + (size_t)z * bzstep + (size_t)pn * bstep; return true; }
};
struct FoldOrder {
    const char* A; const char* B; bool m2; int G, c;
    __device__ __forceinline__ bool next(int i, Unit& u) const {
        const long L = (long)i * G + c; if (L >= 1024) return false;
        const int z = (int)(L >> 2), q = (int)(L & 3), l = z >> 6, b = (z >> 2) & 15, h = z & 3;
        if (!m2) { u.pm = 0; u.pn = q; u.z = z; u.a = A + ((size_t)(l * 4096 + b * 256) * 1024 + h * 256); u.b = B + ((size_t)l * 1024 * 1024 + (size_t)q * 256 * 1024 + h * 256); }
        else     { u.pm = q; u.pn = h; u.z = z >> 2; u.a = A + ((size_t)l * 1024 * 1024 + (size_t)q * 256 * 1024 + h * 256); u.b = B + ((size_t)(l * 4096 + b * 256) * 1024 + h * 256); }
        return true; }
};
struct MoeOrder {
    const char* A; const char* B; size_t astep, bstep_e, bstep_n; const LAS int* tile_e; int nM, nN, G, c;
    __device__ __forceinline__ bool next(int i, Unit& u) const {
        int pm, pn; if (!static_map((long)i * G + c, nM, nN, pm, pn)) return false;
        const int e = __builtin_amdgcn_readfirstlane(tile_e[pm]);
        u.pm = pm; u.pn = pn; u.z = e; u.a = A + (size_t)pm * astep; u.b = B + (size_t)e * bstep_e + (size_t)pn * bstep_n; return true; }
};

struct EpiStore {
    static constexpr bool PERM = true, INPLACE = false, LDSBIAS = false;
    bf16* O; int ldc; size_t zstride; const float* bias; int bzs; float scale; int scale_tiles; float accs = 1.0f;
    __device__ __forceinline__ void operator()(f32x4 (&acc)[2][2][4][2], const Unit& u, int wr, int wc, int fr, int fq, LAS unsigned char*) const {
        const int row0 = u.pm * BM + wr * 64 + fr, col0 = u.pn * BM + wc * 32 + 8 * fq;
        bf16* base = O + (size_t)u.z * zstride;
        const float sc = (u.pn < scale_tiles) ? scale : 1.0f;
        f32x4 bv[2][2];
#pragma unroll
        for (int bj = 0; bj < 2; ++bj)
#pragma unroll
            for (int n = 0; n < 2; ++n) bv[bj][n] = bias ? *(const f32x4*)(bias + (size_t)u.z * bzs + col0 + bj * HALF + 4 * n) : (f32x4){0.f, 0.f, 0.f, 0.f};
#pragma unroll
        for (int ai = 0; ai < 2; ++ai)
#pragma unroll
            for (int m = 0; m < 4; ++m) { bf16* rowp = base + (size_t)(row0 + ai * HALF + m * 16) * ldc + col0;
#pragma unroll
                for (int bj = 0; bj < 2; ++bj) { const f32x4 v0 = (acc[ai][bj][m][0] * accs + bv[bj][0]) * sc, v1 = (acc[ai][bj][m][1] * accs + bv[bj][1]) * sc;
                    u32x4 w; w.x = cvt_pk_bf16(v0[0], v0[1]); w.y = cvt_pk_bf16(v0[2], v0[3]); w.z = cvt_pk_bf16(v1[0], v1[1]); w.w = cvt_pk_bf16(v1[2], v1[3]);
                    *(u32x4*)(rowp + bj * HALF) = w; } }
    }
};
template <bool LB> struct EpiStore8T {
    static constexpr bool PERM = true, INPLACE = false, LDSBIAS = LB;
    unsigned char* O; int ldc; float scale; const float* bias = nullptr; int bzs = 0; float accs = 1.0f; size_t zstride = 0;
    __device__ __forceinline__ void stage_bias(const Unit& u, LAS unsigned char* slot, int wid, int lane) const {
        if (wid == 0) __builtin_amdgcn_global_load_lds((const unsigned*)(bias + (size_t)u.z * bzs + u.pn * BM + 4 * lane), (LAS unsigned*)slot, 16, 0, 0); }
    __device__ __forceinline__ void operator()(f32x4 (&acc)[2][2][4][2], const Unit& u, int wr, int wc, int fr, int fq, LAS unsigned char* xl) const {
        const int row0 = u.pm * BM + wr * 64 + fr, col0 = u.pn * BM + wc * 32 + 8 * fq;
        f32x4 bv[2][2];
#pragma unroll
        for (int bj = 0; bj < 2; ++bj)
#pragma unroll
            for (int n = 0; n < 2; ++n) { if constexpr (LB) bv[bj][n] = *(const LAS f32x4*)(xl + (wc * 32 + 8 * fq + bj * HALF + 4 * n) * 4);
                else bv[bj][n] = bias ? *(const f32x4*)(bias + (size_t)u.z * bzs + col0 + bj * HALF + 4 * n) : (f32x4){0.f, 0.f, 0.f, 0.f}; }
#pragma unroll
        for (int ai = 0; ai < 2; ++ai)
#pragma unroll
            for (int m = 0; m < 4; ++m) { unsigned char* rowp = O + (size_t)u.z * zstride + (size_t)(row0 + ai * HALF + m * 16) * ldc + col0;
#pragma unroll
                for (int bj = 0; bj < 2; ++bj) { const f32x4 v0 = (acc[ai][bj][m][0] * accs + bv[bj][0]) * scale, v1 = (acc[ai][bj][m][1] * accs + bv[bj][1]) * scale;
                    u32x2 w; w.x = cvt_pk4_fp8(v0[0], v0[1], v0[2], v0[3]); w.y = cvt_pk4_fp8(v1[0], v1[1], v1[2], v1[3]);
                    *(u32x2*)(rowp + bj * HALF) = w; } }
    }
};
typedef EpiStore8T<false> EpiStore8;
struct EpiSwiglu {
    static constexpr bool PERM = true, INPLACE = false, LDSBIAS = true;
    unsigned char* HID; const float* b1; float accs;
    __device__ __forceinline__ void stage_bias(const Unit& u, LAS unsigned char* slot, int wid, int lane) const {
        if (wid == 0) __builtin_amdgcn_global_load_lds((const unsigned*)(b1 + (size_t)u.z * 2048 + (lane >> 5) * 1024 + u.pn * 128 + 4 * (lane & 31)), (LAS unsigned*)slot, 16, 0, 0); }
    __device__ __forceinline__ void operator()(f32x4 (&acc)[2][2][4][2], const Unit& u, int wr, int wc, int fr, int fq, LAS unsigned char* xl) const {
        const int row0 = u.pm * BM + wr * 64 + fr, j0 = u.pn * 128 + wc * 32 + 8 * fq;
        f32x4 bgv[2], buv[2];
#pragma unroll
        for (int n = 0; n < 2; ++n) { bgv[n] = *(const LAS f32x4*)(xl + (wc * 32 + 8 * fq + 4 * n) * 4); buv[n] = *(const LAS f32x4*)(xl + (128 + wc * 32 + 8 * fq + 4 * n) * 4); }
#pragma unroll
        for (int ai = 0; ai < 2; ++ai)
#pragma unroll
            for (int m = 0; m < 4; ++m) { float h[8];
#pragma unroll
                for (int n = 0; n < 2; ++n) { const f32x4 gt = acc[ai][0][m][n] * accs + bgv[n], up = acc[ai][1][m][n] * accs + buv[n];
#pragma unroll
                    for (int q = 0; q < 4; ++q) { const float gc = fminf(gt[q], 7.0f), uc = fminf(fmaxf(up[q], -7.0f), 7.0f); h[4 * n + q] = (uc + 1.0f) * gc * fsigmoid(1.702f * gc); } }
                u32x2 w; w.x = cvt_pk4_fp8(h[0], h[1], h[2], h[3]); w.y = cvt_pk4_fp8(h[4], h[5], h[6], h[7]);
                *(u32x2*)(HID + (size_t)(row0 + ai * HALF + m * 16) * DFF + j0) = w; }
    }
};
struct EpiSoftmax {
    static constexpr bool PERM = true, INPLACE = true, LDSBIAS = false;
    unsigned char* P; float sscale;
    __device__ __forceinline__ void operator()(f32x4 (&acc)[2][2][4][2], const Unit& u, int wr, int wc, int fr, int fq, LAS unsigned char* xl) const {
        LAS f32x2* X = (LAS f32x2*)xl;
#pragma unroll
        for (int ai = 0; ai < 2; ++ai)
#pragma unroll
            for (int bj = 0; bj < 2; ++bj)
#pragma unroll
                for (int m = 0; m < 4; ++m)
#pragma unroll
                    for (int n = 0; n < 2; ++n) acc[ai][bj][m][n] = acc[ai][bj][m][n] * sscale;
        float mw[2][4];
#pragma unroll
        for (int ai = 0; ai < 2; ++ai)
#pragma unroll
            for (int m = 0; m < 4; ++m) { float mx = -3.0e38f;
#pragma unroll
                for (int bj = 0; bj < 2; ++bj)
#pragma unroll
                    for (int n = 0; n < 2; ++n) { const f32x4 x = acc[ai][bj][m][n]; mx = fmaxf(mx, fmaxf(fmaxf(x[0], x[1]), fmaxf(x[2], x[3]))); }
                mx = fmaxf(mx, __shfl_xor(mx, 16)); mx = fmaxf(mx, __shfl_xor(mx, 32));
                float s = 0.f;
#pragma unroll
                for (int bj = 0; bj < 2; ++bj)
#pragma unroll
                    for (int n = 0; n < 2; ++n)
#pragma unroll
                        for (int q = 0; q < 4; ++q) { const float e = __expf(acc[ai][bj][m][n][q] - mx); acc[ai][bj][m][n][q] = e; s += e; }
                s += __shfl_xor(s, 16); s += __shfl_xor(s, 32);
                mw[ai][m] = mx;
                if (fq == 0) X[(ai * HALF + wr * 64 + m * 16 + fr) * 4 + wc] = (f32x2){mx, s};
            }
        asm volatile("s_waitcnt lgkmcnt(0)" ::: "memory"); __builtin_amdgcn_s_barrier(); asm volatile("" ::: "memory");
        const int row0 = u.pm * BM + wr * 64 + fr, col0 = u.pn * BM + wc * 32 + 8 * fq;
#pragma unroll
        for (int ai = 0; ai < 2; ++ai)
#pragma unroll
            for (int m = 0; m < 4; ++m) { const int r = ai * HALF + wr * 64 + m * 16 + fr;
                const f32x2 a = X[r * 4 + 0], b = X[r * 4 + 1], c = X[r * 4 + 2], d = X[r * 4 + 3];
                const float mt = fmaxf(fmaxf(a.x, b.x), fmaxf(c.x, d.x));
                const float st = a.y * __expf(a.x - mt) + b.y * __expf(b.x - mt) + c.y * __expf(c.x - mt) + d.y * __expf(d.x - mt);
                const float sc = __expf(mw[ai][m] - mt) * __builtin_amdgcn_rcpf(st) * 256.0f;
                unsigned char* rowp = P + (size_t)(row0 + ai * HALF + m * 16) * D + col0;
#pragma unroll
                for (int bj = 0; bj < 2; ++bj) { const f32x4 e0 = acc[ai][bj][m][0] * sc, e1 = acc[ai][bj][m][1] * sc;
                    u32x2 w; w.x = cvt_pk4_fp8(e0[0], e0[1], e0[2], e0[3]); w.y = cvt_pk4_fp8(e1[0], e1[1], e1[2], e1[3]);
                    *(u32x2*)(rowp + bj * HALF) = w; } }
    }
};
}

constexpr size_t MiB = 1u << 20;
constexpr size_t WS_CTL = 0, CTL_ZERO_BYTES = 1 * MiB;
constexpr size_t WS_TOPI = 1 * MiB, WS_TOPW = 2 * MiB, WS_POSMAP = 3 * MiB, WS_GATES = 4 * MiB  , WS_CNT = 6 * MiB  , WS_TILEE = 7 * MiB  , WS_K2 = 8 * MiB  , WS_WRT = 9 * MiB  , WS_ROWTOK = 10 * MiB  ;
constexpr size_t WS_W = 16 * MiB;
constexpr size_t W_EVIN = WS_W, W_EVOUT = W_EVIN + 14 * MiB, W_GATE = W_EVOUT + 6 * MiB, W_ODIN = W_GATE + 1 * MiB, W_ODOUT = W_ODIN + 12 * MiB;
constexpr size_t W_Q = W_ODOUT + 4 * MiB, W_K = W_Q + 8 * MiB, W_V = W_K + 8 * MiB, W_O = W_V + 8 * MiB, W_1 = W_O + 8 * MiB, W_2 = W_1 + 512 * MiB, W_END = W_2 + 256 * MiB;
static_assert(W_END <= 880 * MiB, "weights");
constexpr size_t WS_MEMB = 880 * MiB, WS_KM = 888 * MiB, WS_VT = 920 * MiB, WS_XB = 960 * MiB, WS_MIX = 1088 * MiB, WS_R = 1216 * MiB, WS_Y = 2316 * MiB, WS_XR8 = 2508 * MiB, WS_M1 = 2572 * MiB, WS_M2 = 2636 * MiB, WS_END = 2700 * MiB;
constexpr size_t R_Z = WS_R, R_U = WS_R + 448 * MiB, R_AG = WS_R + 576 * MiB, R_INP = WS_R + 832 * MiB, R_HB = WS_R + 448 * MiB;
constexpr size_t R_Q = WS_R, R_P = WS_R + 128 * MiB, R_O = WS_R + 256 * MiB, R_XG = WS_R, R_HID = WS_R + 264 * MiB, R_EO = WS_R + 528 * MiB, R_XA8 = WS_R + 320 * MiB;
static_assert(R_EO + 528 * MiB <= WS_Y && (size_t)MAXMT * 256 * 1024 * 2 <= 528 * MiB, "scratch region");
constexpr int CW_BAR = 4096;

constexpr int LDS_BYTES = 147456;
constexpr int XCH_OFF = 131072;
constexpr int MISC_OFF = LDS_BYTES - 256;
constexpr int NWAVES = 8;

#define XB_TMO      128
#define XB_XCNT(j)  (256  + 64 * (j))
#define XB_XSUB(j)  (1280 + 64 * (j))
#define XB_XGEN(j)  (2304 + 64 * (j))
#define XB_TOP      3328
#define XB_TOPGEN   3392
#define XCD_BAR_WORDS 3456
#define XB_SPIN_CAP (1u << 18)
__device__ __forceinline__ unsigned xb_ld(unsigned* p)              { return __hip_atomic_load(p, __ATOMIC_RELAXED, __HIP_MEMORY_SCOPE_AGENT); }
__device__ __forceinline__ unsigned xb_add(unsigned* p, unsigned v) { return __hip_atomic_fetch_add(p, v, __ATOMIC_RELAXED, __HIP_MEMORY_SCOPE_AGENT); }
__device__ __forceinline__ unsigned xb_xcc_id() { return (unsigned)__builtin_amdgcn_s_getreg((3 << 11) | 20) & 0xFu; }
#define XB_SPIN(cond, bar) do { unsigned _sp = 0; while (cond) { __builtin_amdgcn_s_sleep(1); \
    if ((++_sp & 255u) == 0u) { if (xb_ld(&(bar)[XB_TMO])) break; if (_sp > XB_SPIN_CAP) { atomicAdd(&(bar)[XB_TMO], 1u); break; } } } } while (0)
struct XcdBarrier { unsigned* bar; unsigned x; volatile LAS unsigned* st; int wave; };
__device__ __forceinline__ XcdBarrier xcd_barrier_post(unsigned* bar, volatile LAS unsigned* st, int wave) {
    XcdBarrier b; b.bar = bar; b.x = xb_xcc_id(); b.st = st; b.wave = wave;
    if (wave == 0 && lane_id_opaque() == 0) (void)xb_add(&bar[XB_XCNT(b.x)], 1u);
    return b;
}
__device__ __forceinline__ void xcd_barrier_complete(unsigned* bar, unsigned x, unsigned& nloc, unsigned& nx) {
    const unsigned G = gridDim.x * gridDim.y * gridDim.z;
    unsigned sum, cnt, mine, sp = 0u;
    for (;;) {
        sum = 0u; cnt = 0u; mine = 0u;
#pragma unroll
        for (unsigned j = 0; j < 16; ++j) { const unsigned c = xb_ld(&bar[XB_XCNT(j)]); sum += c; cnt += (c > 0u) ? 1u : 0u; mine = (j == x) ? c : mine; }
        if (sum == G) break;
        __builtin_amdgcn_s_sleep(1);
        if ((++sp & 255u) == 0u) { if (xb_ld(&bar[XB_TMO])) break; if (sp > XB_SPIN_CAP) { atomicAdd(&bar[XB_TMO], 1u); break; } }
    }
    nloc = mine > 0u ? mine : 1u; nx = cnt > 0u ? cnt : 1u;
}
__device__ __forceinline__ void xcd_barrier(const XcdBarrier& b) {
    asm volatile("s_waitcnt vmcnt(0)" ::: "memory");
    __syncthreads();
    if (b.wave == 0 && lane_id_opaque() == 0) {
        unsigned* bar = b.bar;
        __builtin_amdgcn_s_waitcnt(0);
        unsigned nloc = b.st[0], nx = b.st[1];
        if (nloc == 0u) { xcd_barrier_complete(bar, b.x, nloc, nx); b.st[0] = nloc; b.st[1] = nx; }
        const unsigned old = xb_add(&bar[XB_XSUB(b.x)], 1u);
        const unsigned gen = old / nloc;
        if (old + 1u == (gen + 1u) * nloc) {
            __builtin_amdgcn_fence(__ATOMIC_RELEASE, "agent");
            asm volatile("s_waitcnt vmcnt(0)" ::: "memory");
            const unsigned og = xb_add(&bar[XB_TOP], 1u);
            const unsigned tg = og / nx;
            if (og + 1u == (tg + 1u) * nx) xb_add(&bar[XB_TOPGEN], 1u);
            else XB_SPIN(xb_ld(&bar[XB_TOPGEN]) == tg, bar);
            __builtin_amdgcn_fence(__ATOMIC_ACQUIRE, "agent");
            xb_add(&bar[XB_XGEN(b.x)], 1u);
            asm volatile("s_waitcnt vmcnt(0)" ::: "memory");
        } else {
            XB_SPIN(xb_ld(&bar[XB_XGEN(b.x)]) == gen, bar);
            __builtin_amdgcn_fence(__ATOMIC_ACQUIRE, "agent");
            asm volatile("s_waitcnt vmcnt(0)" ::: "memory");
        }
    }
    __syncthreads();
}

#define MFMA16(a, b, c) __builtin_amdgcn_mfma_f32_16x16x32_bf16(a, b, c, 0, 0, 0)
__device__ __forceinline__ bf16x8 tr_frag(const LAS bf16* T, int P, int r0, int c0, int fr, int fq) {
    const LAS bf16* p = T + (r0 + 8 * fq + (fr >> 2)) * P + c0 + 4 * (fr & 3);
    const bf16x4 a = __builtin_amdgcn_ds_read_tr16_b64_v4i16((LAS bf16x4*)p), b = __builtin_amdgcn_ds_read_tr16_b64_v4i16((LAS bf16x4*)(p + 4 * P));
    return __builtin_shufflevector(a, b, 0, 1, 2, 3, 4, 5, 6, 7); }
__device__ __forceinline__ void unpack8(const u32x4 w, float (&o)[8]) { o[0] = bf_lo(w.x); o[1] = bf_hi(w.x); o[2] = bf_lo(w.y); o[3] = bf_hi(w.y); o[4] = bf_lo(w.z); o[5] = bf_hi(w.z); o[6] = bf_lo(w.w); o[7] = bf_hi(w.w); }
__device__ __forceinline__ u32x4 pack8(const float (&o)[8]) { u32x4 w; w.x = cvt_pk_bf16(o[0], o[1]); w.y = cvt_pk_bf16(o[2], o[3]); w.z = cvt_pk_bf16(o[4], o[5]); w.w = cvt_pk_bf16(o[6], o[7]); return w; }
struct Ctx { LAS unsigned char* lds; int tid, lane, wave, bid, G; };

__device__ __forceinline__ void tr_load(f32x4 (&v)[16], const float* W, int srcN, int k0, int n0, int lane) {
#pragma unroll
    for (int i = 0; i < 16; ++i) v[i] = *(const f32x4*)(W + (size_t)(k0 + 4 * i + (lane >> 4)) * srcN + n0 + 4 * (lane & 15));
}
__device__ __forceinline__ void tr_store(const f32x4 (&v)[16], int k0, bf16* WT, int dstK, int drow0, LAS float* scr, int lane, float f8scale) {
#pragma unroll
    for (int i = 0; i < 16; ++i) { LAS float* d = scr + (4 * i + (lane >> 4)) * 65 + 4 * (lane & 15); d[0] = v[i][0]; d[1] = v[i][1]; d[2] = v[i][2]; d[3] = v[i][3]; }
    LDS_WAIT();
    const int c = lane & 7;
    if (f8scale != 0.f) {
        unsigned char* W8 = (unsigned char*)WT;
#pragma unroll
        for (int j = 0; j < 8; ++j) { const int n = (lane >> 3) + 8 * j; const LAS float* sp = scr + (8 * c) * 65 + n;
            u32x2 o; o.x = cvt_pk4_fp8(sp[0 * 65] * f8scale, sp[1 * 65] * f8scale, sp[2 * 65] * f8scale, sp[3 * 65] * f8scale); o.y = cvt_pk4_fp8(sp[4 * 65] * f8scale, sp[5 * 65] * f8scale, sp[6 * 65] * f8scale, sp[7 * 65] * f8scale);
            *(u32x2*)(W8 + (size_t)(drow0 + n) * dstK + k0 + 8 * c) = o; }
    } else {
#pragma unroll
        for (int j = 0; j < 8; ++j) { const int n = (lane >> 3) + 8 * j; const LAS float* sp = scr + (8 * c) * 65 + n;
            u32x4 o; o.x = cvt_pk_bf16(sp[0 * 65], sp[1 * 65]); o.y = cvt_pk_bf16(sp[2 * 65], sp[3 * 65]); o.z = cvt_pk_bf16(sp[4 * 65], sp[5 * 65]); o.w = cvt_pk_bf16(sp[6 * 65], sp[7 * 65]);
            *(u32x4*)(WT + (size_t)(drow0 + n) * dstK + k0 + 8 * c) = o; }
    }
    LDS_WAIT();
}
__device__ __forceinline__ void conv_group(const Ctx& X, const float* src, int nb, int K, int N, int srcN, size_t sbs, bf16* dst, size_t dbs, int map, float f8scale = 0.f) {
    LAS float* scr = (LAS float*)(X.lds + X.wave * 16896);
    const int gw = X.bid * NWAVES + X.wave, NGW = X.G * NWAVES;
    const int nblk = N / 64, ipb = (K / 64) * nblk; const long total = (long)nb * ipb;
    f32x4 v[16], vn[16];
    long it = gw;
    if (it < total) { const int bt = (int)(it / ipb), r = (int)(it % ipb); tr_load(v, src + (size_t)bt * sbs, srcN, 64 * (r / nblk), 64 * (r % nblk), X.lane); }
    for (; it < total; it += NGW) {
        const int bt = (int)(it / ipb), r = (int)(it % ipb), kb = r / nblk, n0 = 64 * (r % nblk);
        const long itn = it + NGW;
        if (itn < total) { const int btn = (int)(itn / ipb), rn = (int)(itn % ipb); tr_load(vn, src + (size_t)btn * sbs, srcN, 64 * (rn / nblk), 64 * (rn % nblk), X.lane); }
        __builtin_amdgcn_sched_barrier(0);
        int drow = n0; if (map == 1) { const int j = n0 & 1023; drow = (j >> 7) * 256 + (n0 >= 1024 ? 128 : 0) + (j & 127); }
        bf16* dp = f8scale != 0.f ? (bf16*)((unsigned char*)dst + (size_t)bt * dbs) : dst + (size_t)bt * dbs;
        tr_store(v, 64 * kb, dp, K, drow, scr, X.lane, f8scale);
        __builtin_amdgcn_sched_barrier(0);
#pragma unroll
        for (int i = 0; i < 16; ++i) v[i] = vn[i];
    }
}
__device__ __forceinline__ void cvt_flat(const Ctx& X, const float* src, bf16* dst, size_t n) {
    const size_t gt = (size_t)X.bid * 512 + X.tid, NT = (size_t)X.G * 512;
    for (size_t i = gt; i < n / 8; i += NT) { const f32x4 a = *(const f32x4*)(src + i * 8), b = *(const f32x4*)(src + i * 8 + 4);
        u32x4 w; w.x = cvt_pk_bf16(a[0], a[1]); w.y = cvt_pk_bf16(a[2], a[3]); w.z = cvt_pk_bf16(b[0], b[1]); w.w = cvt_pk_bf16(b[2], b[3]); *(u32x4*)(dst + i * 8) = w; }
}

__device__ __forceinline__ void cvt_flat8(const Ctx& X, const float* src, unsigned char* dst, size_t n, float sc = 1.0f) {
    const size_t gt = (size_t)X.bid * 512 + X.tid, NT = (size_t)X.G * 512;
    for (size_t i = gt; i < n / 8; i += NT) { const f32x4 a = *(const f32x4*)(src + i * 8), b = *(const f32x4*)(src + i * 8 + 4);
        u32x2 w; w.x = cvt_pk4_fp8(a[0] * sc, a[1] * sc, a[2] * sc, a[3] * sc); w.y = cvt_pk4_fp8(b[0] * sc, b[1] * sc, b[2] * sc, b[3] * sc); *(u32x2*)(dst + i * 8) = w; }
}

template <bool MOE, int ROWS>
__device__ __forceinline__ void ln_phase(const Ctx& X, const float* xin_f32, const bf16* f, const int* posmap, const float* topw, const float* g, const float* b, float* xout_f32, bf16* xb, unsigned char* xr8, unsigned char* x8 = nullptr) {
    const int gw = X.bid * NWAVES + X.wave, NGW = X.G * NWAVES, lane = X.lane;
    f32x4 gv[4], bv[4];
#pragma unroll
    for (int j = 0; j < 4; ++j) { gv[j] = *(const f32x4*)(g + 4 * lane + 256 * j); bv[j] = *(const f32x4*)(b + 4 * lane + 256 * j); }
    for (int base = gw * ROWS; base < T; base += NGW * ROWS) {
        f32x4 v[ROWS][4];
#pragma unroll
        for (int r = 0; r < ROWS; ++r)
#pragma unroll
            for (int j = 0; j < 4; ++j) { const size_t o_ = (size_t)(base + r) * D + 4 * lane + 256 * j;
                if (xin_f32) v[r][j] = *(const f32x4*)(xin_f32 + o_);
                else { const u32x2 w = *(const u32x2*)(xb + o_); const unsigned q8 = *(const unsigned*)(xr8 + o_);
                    v[r][j] = (f32x4){bf_lo(w.x), bf_hi(w.x), bf_lo(w.y), bf_hi(w.y)} + (f32x4){__builtin_amdgcn_cvt_f32_fp8(q8, 0), __builtin_amdgcn_cvt_f32_fp8(q8, 1), __builtin_amdgcn_cvt_f32_fp8(q8, 2), __builtin_amdgcn_cvt_f32_fp8(q8, 3)} * XR_INV; } }
        if (MOE) {
            const int vz = X.tid >> 10;
            unsigned fw[ROWS][4][4]; f32x4 tw[ROWS];
#pragma unroll
            for (int r = 0; r < ROWS; ++r) { const int4 ps = *(const int4*)(posmap + (size_t)(base + r) * 4 + vz); tw[r] = *(const f32x4*)(topw + (size_t)(base + r) * 4 + vz);
                const int pp[4] = {ps.x, ps.y, ps.z, ps.w};
#pragma unroll
                for (int s = 0; s < 4; ++s)
#pragma unroll
                    for (int j = 0; j < 4; ++j) fw[r][s][j] = *(const unsigned*)((const unsigned char*)f + (size_t)pp[s] * D + 4 * lane + 256 * j); }
#pragma unroll
            for (int r = 0; r < ROWS; ++r)
#pragma unroll
                for (int j = 0; j < 4; ++j) { v[r][j] = v[r][j] * DN_ALPHA;
#pragma unroll
                    for (int s = 0; s < 4; ++s) { const unsigned w = fw[r][s][j]; const float ts = tw[r][s] * (1.0f / EO_SCALE);
                        v[r][j] += (f32x4){__builtin_amdgcn_cvt_f32_fp8(w, 0), __builtin_amdgcn_cvt_f32_fp8(w, 1), __builtin_amdgcn_cvt_f32_fp8(w, 2), __builtin_amdgcn_cvt_f32_fp8(w, 3)} * ts; } }
        } else {
            u32x2 fw[ROWS][4];
#pragma unroll
            for (int r = 0; r < ROWS; ++r)
#pragma unroll
                for (int j = 0; j < 4; ++j) fw[r][j] = *(const u32x2*)(f + (size_t)(base + r) * D + 4 * lane + 256 * j);
#pragma unroll
            for (int r = 0; r < ROWS; ++r)
#pragma unroll
                for (int j = 0; j < 4; ++j) { const u32x2 w = fw[r][j]; v[r][j] = v[r][j] * DN_ALPHA + (f32x4){bf_lo(w.x), bf_hi(w.x), bf_lo(w.y), bf_hi(w.y)}; }
        }
        float mean[ROWS], rstd[ROWS];
#pragma unroll
        for (int r = 0; r < ROWS; ++r) { float s = 0.f;
#pragma unroll
            for (int j = 0; j < 4; ++j) s += (v[r][j][0] + v[r][j][1]) + (v[r][j][2] + v[r][j][3]);
            mean[r] = wave_sum(s) * (1.f / D); }
#pragma unroll
        for (int r = 0; r < ROWS; ++r) { float s2 = 0.f;
#pragma unroll
            for (int j = 0; j < 4; ++j) { v[r][j] = v[r][j] - mean[r]; s2 += (v[r][j][0] * v[r][j][0] + v[r][j][1] * v[r][j][1]) + (v[r][j][2] * v[r][j][2] + v[r][j][3] * v[r][j][3]); }
            rstd[r] = 1.f / sqrtf(wave_sum(s2) * (1.f / D) + LN_EPS); }
#pragma unroll
        for (int r = 0; r < ROWS; ++r)
#pragma unroll
            for (int j = 0; j < 4; ++j) { const f32x4 o = v[r][j] * rstd[r] * gv[j] + bv[j];
                const size_t o_ = (size_t)(base + r) * D + 4 * lane + 256 * j;
                if (xout_f32) { *(f32x4*)(xout_f32 + o_) = o; continue; }
                u32x2 w; w.x = cvt_pk_bf16(o[0], o[1]); w.y = cvt_pk_bf16(o[2], o[3]); *(u32x2*)(xb + o_) = w;
                *(unsigned*)(xr8 + o_) = cvt_pk4_fp8((o[0] - bf_lo(w.x)) * XR_SCALE, (o[1] - bf_hi(w.x)) * XR_SCALE, (o[2] - bf_lo(w.y)) * XR_SCALE, (o[3] - bf_hi(w.y)) * XR_SCALE);
                if (x8) *(unsigned*)(x8 + (size_t)(base + r) * D + 4 * lane + 256 * j) = cvt_pk4_fp8(o[0], o[1], o[2], o[3]); }
    }
}

__device__ __forceinline__ void ya_phase(const Ctx& X, const bf16* Z, const float* conv_a, bf16* Y) {
    const size_t gt = (size_t)X.bid * 512 + X.tid, NT = (size_t)X.G * 512, items = (size_t)T * 64;
    const int cg = (int)(gt & 63), c0 = cg * 8;
    f32x4 w0[3], w1[3];
#pragma unroll
    for (int j = 0; j < 3; ++j) { w0[j] = *(const f32x4*)(conv_a + j * 512 + c0); w1[j] = *(const f32x4*)(conv_a + j * 512 + c0 + 4); }
    for (size_t it = gt; it < items; it += 4 * NT) {
        u32x4 rab[4], rac[4][3], rax[4][3];
#pragma unroll
        for (int u = 0; u < 4; ++u) { const int t = (int)((it + u * NT) >> 6), pos = t & (SEQ - 1);
            rab[u] = *(const u32x4*)(Z + (size_t)t * EV_IN + c0);
#pragma unroll
            for (int j = 0; j < 3; ++j) { const bool ok = pos - 2 + j >= 0; const size_t tt = ok ? (size_t)(t - 2 + j) : (size_t)t;
                rac[u][j] = *(const u32x4*)(Z + tt * EV_IN + 512 + c0); rax[u][j] = *(const u32x4*)(Z + tt * EV_IN + 1024 + c0);
                if (!ok) { rac[u][j] = (u32x4){0u, 0u, 0u, 0u}; } } }
        __builtin_amdgcn_sched_barrier(0);
#pragma unroll
        for (int u = 0; u < 4; ++u) { const int t = (int)((it + u * NT) >> 6); float ab[8], acc[8];
            unpack8(rab[u], ab);
#pragma unroll
            for (int q = 0; q < 8; ++q) acc[q] = 0.f;
#pragma unroll
            for (int j = 0; j < 3; ++j) { float ac[8], ax[8]; unpack8(rac[u][j], ac); unpack8(rax[u][j], ax);
#pragma unroll
                for (int q = 0; q < 4; ++q) { acc[q] += w0[j][q] * (ac[q] * ax[q]); acc[4 + q] += w1[j][q] * (ac[4 + q] * ax[4 + q]); } }
#pragma unroll
            for (int q = 0; q < 8; ++q) acc[q] *= ab[q];
            *(u32x4*)(Y + (size_t)t * EV_Y + c0) = pack8(acc); }
    }
}

__device__ __forceinline__ float gelu_tanh(float x) { const float u = 0.7978845608028654f * (x + 0.044715f * x * x * x); const float e = __expf(2.f * u); const float th = 1.f - 2.f * __builtin_amdgcn_rcpf(e + 1.f); return 0.5f * x * (1.f + th); }
__device__ __forceinline__ void lru_phase(const Ctx& X, const bf16* Z, const bf16* WG  , const float* conv_b, const float* conv_bb, const float* br, const float* bi, const float* k2, bf16* Y) {
    constexpr int RS = 136;
    LAS bf16* WS = (LAS bf16*)X.lds;
    LAS bf16* US = (LAS bf16*)(X.lds + 34816);
    LAS f32x2* AH = (LAS f32x2*)(X.lds + 52224);
    LAS bf16* BG = (LAS bf16*)(X.lds + 84992);
    LAS bf16* YS = (LAS bf16*)(X.lds + 93184);
    LAS f32x2* EX = (LAS f32x2*)(X.lds + 101376);
    const int tid = X.tid, lane = X.lane, w = X.wave, fr = lane & 15, fq = lane >> 4, cg = tid & 15, tb = w & 3, nh = w >> 2;
    for (int unit = X.bid; unit < 256; unit += X.G) {
        const int b = unit >> 4, h = (unit >> 1) & 7, half = unit & 1, hc0 = h * 128, e0 = hc0 + half * 64;
        const size_t row0 = (size_t)b * SEQ;
        __syncthreads();
#pragma unroll
        for (int i = 0; i < 4; ++i) { const int p = tid + 512 * i, n = p >> 4, cp = p & 15; const int srow = (n < 64) ? half * 64 + n : 128 + half * 64 + (n - 64);
            *(LAS u32x4*)(WS + n * RS + cp * 8) = *(const u32x4*)(WG + ((size_t)h * 256 + srow) * 128 + cp * 8); }
        float wcv[4][8], bcv[8];
#pragma unroll
        for (int q = 0; q < 8; ++q) { bcv[q] = conv_bb[hc0 + 8 * cg + q];
#pragma unroll
            for (int j = 0; j < 4; ++j) wcv[j][q] = conv_b[j * 1024 + hc0 + 8 * cg + q]; }
        float brv[2], biv[2], k2v[2];
#pragma unroll
        for (int nbi = 0; nbi < 2; ++nbi) { const int ch = e0 + 16 * (2 * nh + nbi) + fr; brv[nbi] = br[ch]; biv[nbi] = bi[ch]; k2v[nbi] = k2[ch]; }
        float carry = 0.f;
        u32x4 pu[2][4], pg;
#define LRU_LOAD(c) do { _Pragma("unroll") for (int it = 0; it < 2; ++it) { const int t_ = (tid + 512 * it) >> 4; \
                _Pragma("unroll") for (int j = 0; j < 4; ++j) { const int tt = (c) * 64 + t_ - 3 + j; \
                    pu[it][j] = (tt >= 0) ? *(const u32x4*)(Z + (row0 + tt) * EV_IN + 1536 + hc0 + 8 * cg) : (u32x4){0u, 0u, 0u, 0u}; } } \
            pg = *(const u32x4*)(Z + (row0 + (size_t)(c) * 64 + (tid >> 3)) * EV_IN + 2560 + e0 + 8 * (tid & 7)); } while (0)
        LRU_LOAD(0);
        for (int c = 0; c < 64; ++c) {
#pragma unroll
            for (int it = 0; it < 2; ++it) { const int t = (tid + 512 * it) >> 4; float u8[8];
#pragma unroll
                for (int q = 0; q < 8; ++q) u8[q] = bcv[q];
#pragma unroll
                for (int j = 0; j < 4; ++j) { float x8[8]; unpack8(pu[it][j], x8);
#pragma unroll
                    for (int q = 0; q < 8; ++q) u8[q] += wcv[j][q] * x8[q]; }
                *(LAS u32x4*)(US + t * RS + 8 * cg) = pack8(u8); }
            *(LAS u32x4*)(BG + (tid >> 3) * 64 + 8 * (tid & 7)) = pg;
            WG_BAR();
            if (c + 1 < 64) LRU_LOAD(c + 1);
            { bf16x8 af[4];
#pragma unroll
              for (int ks = 0; ks < 4; ++ks) af[ks] = *(const LAS bf16x8*)(US + (16 * tb + fr) * RS + 32 * ks + 8 * fq);
#pragma unroll
              for (int nbi = 0; nbi < 2; ++nbi) { const int nb = 2 * nh + nbi; f32x4 aR = (f32x4){0.f, 0.f, 0.f, 0.f}, aI = (f32x4){0.f, 0.f, 0.f, 0.f};
#pragma unroll
                for (int ks = 0; ks < 4; ++ks) { const bf16x8 wr_ = *(const LAS bf16x8*)(WS + (16 * nb + fr) * RS + 32 * ks + 8 * fq), wi_ = *(const LAS bf16x8*)(WS + (64 + 16 * nb + fr) * RS + 32 * ks + 8 * fq);
                    aR = MFMA16(af[ks], wr_, aR); aI = MFMA16(af[ks], wi_, aI); }
#pragma unroll
                for (int r = 0; r < 4; ++r) { const int t = 16 * tb + 4 * fq + r, ch = 16 * nb + fr;
                    const float rg = fsigmoid(aR[r] + brv[nbi]), ig = fsigmoid(aI[r] + biv[nbi]); const float a = __builtin_amdgcn_exp2f(rg * k2v[nbi]);
                    const float uu = bf1(US[t * RS + half * 64 + ch]);
                    AH[t * 64 + ch] = (f32x2){a, __builtin_sqrtf(fmaxf(1.0f - a * a, 0.f)) * (ig * uu)}; } } }
            WG_BAR();
            { float av[8], xv[8]; float A = 1.f, H = 0.f;
#pragma unroll
              for (int i = 0; i < 8; ++i) { const f32x2 e = AH[(8 * w + i) * 64 + lane]; av[i] = e.x; xv[i] = e.y; H = e.x * H + e.y; A *= e.x; }
              LAS f32x2* ex = EX + (c & 1) * 512;
              ex[w * 64 + lane] = (f32x2){A, H};
              WG_BAR();
              float cc = carry, cin = carry;
#pragma unroll
              for (int ww = 0; ww < 8; ++ww) { const f32x2 e = ex[ww * 64 + lane]; if (ww == w) cin = cc; cc = e.x * cc + e.y; }
              carry = cc;
              float hh = cin;
#pragma unroll
              for (int i = 0; i < 8; ++i) { hh = av[i] * hh + xv[i]; const float gv = bf1(BG[(8 * w + i) * 64 + lane]);
                  YS[(8 * w + i) * 64 + lane] = (bf16)(cvt_pk_bf16(gelu_tanh(gv) * hh, 0.f) & 0xffffu); } }
            WG_BAR();
            *(u32x4*)(Y + (row0 + (size_t)c * 64 + (tid >> 3)) * EV_Y + 512 + e0 + 8 * (tid & 7)) = *(const LAS u32x4*)(YS + (tid >> 3) * 64 + 8 * (tid & 7));
        }
#undef LRU_LOAD
    }
    __syncthreads();
}

__device__ __forceinline__ void gates_phase(const Ctx& X, const bf16* xb, const unsigned char* xr8, const float* w_in  , const float* bg, float* GATES) {
    LAS float* w8 = (LAS float*)X.lds;
    for (int idx = X.tid; idx < 8192; idx += 512) { const int k = idx >> 3, g = idx & 7; w8[g * 1024 + k] = w_in[(size_t)k * OD_IN + OD_INP + g]; }
    __syncthreads();
    const int gw = X.bid * NWAVES + X.wave, NGW = X.G * NWAVES, lane = X.lane;
    const float bgl = bg[lane & 7];
    for (int base = gw * 4; base < T; base += NGW * 4) {
        f32x4 v[4][4];
#pragma unroll
        for (int r = 0; r < 4; ++r)
#pragma unroll
            for (int j = 0; j < 4; ++j) { const size_t o_ = (size_t)(base + r) * D + 4 * lane + 256 * j; const u32x2 w = *(const u32x2*)(xb + o_); const unsigned q8 = *(const unsigned*)(xr8 + o_);
                v[r][j] = (f32x4){bf_lo(w.x), bf_hi(w.x), bf_lo(w.y), bf_hi(w.y)} + (f32x4){__builtin_amdgcn_cvt_f32_fp8(q8, 0), __builtin_amdgcn_cvt_f32_fp8(q8, 1), __builtin_amdgcn_cvt_f32_fp8(q8, 2), __builtin_amdgcn_cvt_f32_fp8(q8, 3)} * XR_INV; }
        float mine[4] = {0.f, 0.f, 0.f, 0.f};
#pragma unroll
        for (int g = 0; g < 8; ++g) { f32x4 wv[4];
#pragma unroll
            for (int j = 0; j < 4; ++j) wv[j] = *(const LAS f32x4*)(w8 + g * 1024 + 4 * lane + 256 * j);
#pragma unroll
            for (int r = 0; r < 4; ++r) { float s = 0.f;
#pragma unroll
                for (int j = 0; j < 4; ++j) s += (v[r][j][0] * wv[j][0] + v[r][j][1] * wv[j][1]) + (v[r][j][2] * wv[j][2] + v[r][j][3] * wv[j][3]);
                s = wave_sum(s); if (lane == g) mine[r] = s; } }
        if (lane < 8) {
#pragma unroll
            for (int r = 0; r < 4; ++r) { float val = mine[r] + bgl;
                if (lane >= 4) val = fminf(val, 0.f) - log1pf(__expf(-fabsf(val)));
                GATES[(size_t)(base + r) * 8 + lane] = val; } }
    }
    __syncthreads();
}

__device__ __forceinline__ void mlstm_phase(const Ctx& X, const bf16* ZO, const float* GATES, bf16* HB) {
    constexpr int RS = 136;
    LAS unsigned char* lds = X.lds;
    LAS bf16* KS = (LAS bf16*)(lds);
    constexpr int VS_P = 72;
    LAS bf16* VS = (LAS bf16*)(lds + 34816);
    LAS bf16* CT = (LAS bf16*)(lds + 87040);
    LAS bf16* PS = (LAS bf16*)(lds + 104448) + X.wave * 16 * RS;
    LAS float* SC = (LAS float*)(lds + 139264);
    LAS float *s_a = SC, *s_M = SC + 128, *s_wi = SC + 256, *s_enm = SC + 384, *s_wg = SC + 512, *s_n = SC + 640, *s_misc = SC + 768;
    const int tid = X.tid, lane = X.lane, w = X.wave, fr = lane & 15, fq = lane >> 4;
    for (int unit = X.bid; unit < 256; unit += X.G) {
        const int dvs = unit & 3, bh = unit >> 2, h = bh & 3, b = bh >> 2;
        const size_t row0 = (size_t)b * SEQ;
        const bf16* qbase = ZO + h * 128; const bf16* kbase = ZO + 512 + h * 128; const bf16* vbase = ZO + 1024 + h * 256 + dvs * 64;
        __syncthreads();
        for (int i = tid; i < 64 * RS / 2; i += 512) ((LAS unsigned*)CT)[i] = 0u;
        if (tid < 128) s_n[tid] = 0.f;
        f32x4 accC[4];
#pragma unroll
        for (int i = 0; i < 4; ++i) accC[i] = (f32x4){0.f, 0.f, 0.f, 0.f};
        float nreg = 0.f, m_st = 0.f;
        u32x4 kreg[4], vreg[2]; bf16x8 qn[4]; float gi0 = 0.f, gi1 = 0.f, gf0 = 0.f, gf1 = 0.f;
#define ML_LOAD(c) do { const size_t t0_ = row0 + (size_t)(c) * 128; \
            _Pragma("unroll") for (int i = 0; i < 4; ++i) { const int p = tid + 512 * i; kreg[i] = *(const u32x4*)(kbase + (t0_ + (p >> 4)) * OD_INP + (p & 15) * 8); }     \
            _Pragma("unroll") for (int i = 0; i < 2; ++i) { const int p = tid + 512 * i; vreg[i] = *(const u32x4*)(vbase + (t0_ + (p >> 3)) * OD_INP + (p & 7) * 8); } \
            _Pragma("unroll") for (int ks = 0; ks < 4; ++ks) qn[ks] = *(const bf16x8*)(qbase + (t0_ + 16 * w + fr) * OD_INP + 32 * ks + 8 * fq); \
            if (w == 7) { gi0 = GATES[(t0_ + 2 * lane) * 8 + h]; gi1 = GATES[(t0_ + 2 * lane + 1) * 8 + h]; gf0 = GATES[(t0_ + 2 * lane) * 8 + 4 + h]; gf1 = GATES[(t0_ + 2 * lane + 1) * 8 + 4 + h]; } } while (0)
        ML_LOAD(0);
        for (int c = 0; c < 32; ++c) {
            const size_t t0 = row0 + (size_t)c * 128;
#pragma unroll
            for (int i = 0; i < 4; ++i) { const int p = tid + 512 * i, row = p >> 4, cp = p & 15; *(LAS u32x4*)(KS + row * RS + cp * 8) = kreg[i]; }
#pragma unroll
            for (int i = 0; i < 2; ++i) { const int p = tid + 512 * i, row = p >> 3, cp = p & 7; *(LAS u32x4*)(VS + row * VS_P + cp * 8) = vreg[i]; }
            bf16x8 qc[4];
#pragma unroll
            for (int ks = 0; ks < 4; ++ks) qc[ks] = qn[ks];
            if (w == 7) {
                float sc = gf0 + gf1;
#pragma unroll
                for (int off = 1; off < 64; off <<= 1) { const float t = __shfl_up(sc, off); if (lane >= off) sc += t; }
                const float b1 = sc, b0 = sc - gf1, a0 = gi0 - b0, a1 = gi1 - b1;
                float sm = fmaxf(a0, a1);
#pragma unroll
                for (int off = 1; off < 64; off <<= 1) { const float t = __shfl_up(sm, off); if (lane >= off) sm = fmaxf(sm, t); }
                float prev = __shfl_up(sm, 1); if (lane == 0) prev = -3.0e38f;
                const float M0 = fmaxf(m_st, fmaxf(prev, a0)), M1 = fmaxf(m_st, sm);
                const float Ml = __shfl(M1, 63), bend = __shfl(b1, 63);
                s_a[2 * lane] = a0; s_a[2 * lane + 1] = a1; s_M[2 * lane] = M0; s_M[2 * lane + 1] = M1;
                s_wi[2 * lane] = __expf(m_st - M0); s_wi[2 * lane + 1] = __expf(m_st - M1);
                s_enm[2 * lane] = __expf(-(b0 + M0)); s_enm[2 * lane + 1] = __expf(-(b1 + M1));
                s_wg[2 * lane] = __expf(a0 - Ml); s_wg[2 * lane + 1] = __expf(a1 - Ml);
                if (lane == 0) s_misc[0] = __expf(m_st - Ml);
                m_st = bend + Ml;
            }
            WG_BAR();
            if (c + 1 < 32) ML_LOAD(c + 1);
            const float Mt = s_M[16 * w + fr]; float rs = 0.f;
#pragma unroll
            for (int sb = 0; sb < 8; ++sb) {
                if (sb > w) { *(LAS u32x2*)(PS + fr * RS + 16 * sb + 4 * fq) = (u32x2){0u, 0u}; continue; }
                f32x4 acc = (f32x4){0.f, 0.f, 0.f, 0.f};
#pragma unroll
                for (int ks = 0; ks < 4; ++ks) { const bf16x8 kf = *(const LAS bf16x8*)(KS + (16 * sb + fr) * RS + 32 * ks + 8 * fq); acc = MFMA16(kf, qc[ks], acc); }
                const f32x4 av = *(const LAS f32x4*)(s_a + 16 * sb + 4 * fq); float pv[4];
#pragma unroll
                for (int r = 0; r < 4; ++r) { const int s = 16 * sb + 4 * fq + r, tt = 16 * w + fr; const float e = __expf(av[r] - Mt); const float v = (s <= tt) ? acc[r] * e : 0.f; rs += v; pv[r] = v; }
                *(LAS u32x2*)(PS + fr * RS + 16 * sb + 4 * fq) = (u32x2){cvt_pk_bf16(pv[0], pv[1]), cvt_pk_bf16(pv[2], pv[3])};
            }
            rs += __shfl_xor(rs, 16); rs += __shfl_xor(rs, 32);
            float qn_ = 0.f;
#pragma unroll
            for (int ks = 0; ks < 4; ++ks) { const f32x4 n0 = *(const LAS f32x4*)(s_n + 32 * ks + 8 * fq), n1 = *(const LAS f32x4*)(s_n + 32 * ks + 8 * fq + 4);
                const u32x4 qw = __builtin_bit_cast(u32x4, qc[ks]);
                qn_ += bf_lo(qw.x) * n0[0] + bf_hi(qw.x) * n0[1] + bf_lo(qw.y) * n0[2] + bf_hi(qw.y) * n0[3] + bf_lo(qw.z) * n1[0] + bf_hi(qw.z) * n1[1] + bf_lo(qw.w) * n1[2] + bf_hi(qw.w) * n1[3]; }
            qn_ += __shfl_xor(qn_, 16); qn_ += __shfl_xor(qn_, 32);
            const float wi = s_wi[16 * w + fr], enm = s_enm[16 * w + fr];
            const float den = rs + wi * qn_; const float hden = 1.0f / fmaxf(fabsf(den), enm);
            f32x4 accH[4], accI[4];
#pragma unroll
            for (int i = 0; i < 4; ++i) { accH[i] = (f32x4){0.f, 0.f, 0.f, 0.f}; accI[i] = (f32x4){0.f, 0.f, 0.f, 0.f}; }
#pragma unroll
            for (int ks = 0; ks < 4; ++ks) { if (32 * ks > 16 * w + 15) continue;
                const bf16x8 pf = *(const LAS bf16x8*)(PS + fr * RS + 32 * ks + 8 * fq);
#pragma unroll
                for (int dvb = 0; dvb < 4; ++dvb) { const bf16x8 vf = tr_frag(VS, VS_P, 32 * ks, 16 * dvb, fr, fq); accH[dvb] = MFMA16(vf, pf, accH[dvb]); } }
#pragma unroll
            for (int ks = 0; ks < 4; ++ks)
#pragma unroll
                for (int dvb = 0; dvb < 4; ++dvb) { const bf16x8 cf = *(const LAS bf16x8*)(CT + (16 * dvb + fr) * RS + 32 * ks + 8 * fq); accI[dvb] = MFMA16(cf, qc[ks], accI[dvb]); }
#pragma unroll
            for (int dvb = 0; dvb < 4; ++dvb) { float o[4];
#pragma unroll
                for (int r = 0; r < 4; ++r) o[r] = (accH[dvb][r] + wi * accI[dvb][r]) * hden;
                *(u32x2*)(HB + (t0 + 16 * w + fr) * D + h * 256 + dvs * 64 + 16 * dvb + 4 * fq) = (u32x2){cvt_pk_bf16(o[0], o[1]), cvt_pk_bf16(o[2], o[3])}; }
            const float decay = s_misc[0];
#pragma unroll
            for (int i = 0; i < 4; ++i) accC[i] = accC[i] * decay;
            float nadd = 0.f;
#pragma unroll
            for (int ks = 0; ks < 4; ++ks) { const u32x4 kw = __builtin_bit_cast(u32x4, tr_frag(KS, RS, 32 * ks, 16 * w, fr, fq));
                const f32x4 g0 = *(const LAS f32x4*)(s_wg + 32 * ks + 8 * fq), g1 = *(const LAS f32x4*)(s_wg + 32 * ks + 8 * fq + 4);
                const float f0 = bf_lo(kw.x) * g0[0], f1 = bf_hi(kw.x) * g0[1], f2 = bf_lo(kw.y) * g0[2], f3 = bf_hi(kw.y) * g0[3], f4 = bf_lo(kw.z) * g1[0], f5 = bf_hi(kw.z) * g1[1], f6 = bf_lo(kw.w) * g1[2], f7 = bf_hi(kw.w) * g1[3];
                nadd += ((f0 + f1) + (f2 + f3)) + ((f4 + f5) + (f6 + f7));
                u32x4 sw; sw.x = cvt_pk_bf16(f0, f1); sw.y = cvt_pk_bf16(f2, f3); sw.z = cvt_pk_bf16(f4, f5); sw.w = cvt_pk_bf16(f6, f7);
                const bf16x8 ktw = __builtin_bit_cast(bf16x8, sw);
#pragma unroll
                for (int dvb = 0; dvb < 4; ++dvb) { const bf16x8 vf = tr_frag(VS, VS_P, 32 * ks, 16 * dvb, fr, fq); accC[dvb] = MFMA16(ktw, vf, accC[dvb]); } }
            nadd += __shfl_xor(nadd, 16); nadd += __shfl_xor(nadd, 32);
            nreg = decay * nreg + nadd;
            WG_BAR();
#pragma unroll
            for (int dvb = 0; dvb < 4; ++dvb) *(LAS u32x2*)(CT + (16 * dvb + fr) * RS + 16 * w + 4 * fq) = (u32x2){cvt_pk_bf16(accC[dvb][0], accC[dvb][1]), cvt_pk_bf16(accC[dvb][2], accC[dvb][3])};
            if (fq == 0) s_n[16 * w + fr] = nreg;
        }
#undef ML_LOAD
    }
    __syncthreads();
}

__device__ __forceinline__ void hnorm_phase(const Ctx& X, const bf16* HB, const bf16* ZO, const float* ng, bf16* Y) {
    const int gw = X.bid * NWAVES + X.wave, NGW = X.G * NWAVES, lane = X.lane;
    float gv[16];
#pragma unroll
    for (int j = 0; j < 4; ++j) { const f32x4 t = *(const f32x4*)(ng + 16 * lane + 4 * j); gv[4 * j] = t[0]; gv[4 * j + 1] = t[1]; gv[4 * j + 2] = t[2]; gv[4 * j + 3] = t[3]; }
    for (int base = gw * 4; base < T; base += NGW * 4) {
        u32x4 hw[4][2], ow[4][2];
#pragma unroll
        for (int r = 0; r < 4; ++r)
#pragma unroll
            for (int q = 0; q < 2; ++q) { hw[r][q] = *(const u32x4*)(HB + (size_t)(base + r) * D + 16 * lane + 8 * q); ow[r][q] = *(const u32x4*)(ZO + (size_t)(base + r) * OD_INP + 2048 + 16 * lane + 8 * q); }
#pragma unroll
        for (int r = 0; r < 4; ++r) { float hv[16], ov[16]; { float t8[8]; unpack8(hw[r][0], t8);
#pragma unroll
                for (int q = 0; q < 8; ++q) hv[q] = t8[q]; unpack8(hw[r][1], t8);
#pragma unroll
                for (int q = 0; q < 8; ++q) hv[8 + q] = t8[q]; unpack8(ow[r][0], t8);
#pragma unroll
                for (int q = 0; q < 8; ++q) ov[q] = t8[q]; unpack8(ow[r][1], t8);
#pragma unroll
                for (int q = 0; q < 8; ++q) ov[8 + q] = t8[q]; }
            float ss = 0.f;
#pragma unroll
            for (int q = 0; q < 16; ++q) ss += hv[q] * hv[q];
            ss = row16_sum(ss);
            const float ri = 1.0f / sqrtf(ss * (1.f / 256.f) + RMS_EPS);
            float y0[8], y1[8];
#pragma unroll
            for (int q = 0; q < 8; ++q) { y0[q] = fsigmoid(ov[q]) * (hv[q] * ri * gv[q]); y1[q] = fsigmoid(ov[8 + q]) * (hv[8 + q] * ri * gv[8 + q]); }
            *(u32x4*)(Y + (size_t)(base + r) * D + 16 * lane) = pack8(y0); *(u32x4*)(Y + (size_t)(base + r) * D + 16 * lane + 8) = pack8(y1); }
    }
}

__device__ __forceinline__ void router_phase(const Ctx& X, const bf16* xb, const unsigned char* xr8, const float* wf  , const float* brt, int* topi, float* topw, int* cnt) {
    LAS unsigned char* SB = X.lds + X.wave * 13312;
    LAS unsigned char* SR = SB + 8704;
    LAS float* LG = (LAS float*)(X.lds + 106496) + X.wave * (32 * 33);
    LAS int* hist = (LAS int*)(X.lds + 140288);
    const int lane = X.lane, tl = lane & 31, hh = lane >> 5;
    for (int tile = X.bid; tile < T / 256; tile += X.G) {
        if (X.tid < 32) hist[X.tid] = 0;
        __syncthreads();
        const int tok0 = tile * 256 + X.wave * 32;
        const int token = tok0 + tl;
        const GAS bf16* xg_b = (const GAS bf16*)(xb + (size_t)(tok0 + (lane >> 4)) * D + 8 * (lane & 15));
        const GAS unsigned char* xg_r = (const GAS unsigned char*)(xr8 + (size_t)(tok0 + (lane >> 3)) * D + 16 * (lane & 7));
        const GAS float* wp = (const GAS float*)wf + lane * 4;
        LAS unsigned char* swb = SB + (lane >> 4) * 272 + (lane & 15) * 16;
        LAS unsigned char* swr = SR + (lane >> 3) * 144 + (lane & 7) * 16;
        const LAS unsigned char* srb = SB + tl * 272 + hh * 128;
        const LAS unsigned char* srr = SR + tl * 144 + hh * 64;
        f32x16 acc;
#pragma unroll
        for (int r = 0; r < 16; ++r) acc[r] = 0.f;
        u32x4 xg[12], xf[3]; f32x4 wa[4], wc_[4];
#define RT_XLOAD(c_) do { _Pragma("unroll") for (int i = 0; i < 8; ++i) xg[i] = *(const GAS u32x4*)(xg_b + (size_t)(4 * i) * D + 128 * (c_)); \
            _Pragma("unroll") for (int i = 0; i < 4; ++i) xg[8 + i] = *(const GAS u32x4*)(xg_r + (size_t)(8 * i) * D + 128 * (c_)); } while (0)
#define RT_XSTAGE() do { _Pragma("unroll") for (int i = 0; i < 8; ++i) *(LAS u32x4*)(swb + i * 4 * 272) = xg[i]; \
            _Pragma("unroll") for (int i = 0; i < 4; ++i) *(LAS u32x4*)(swr + i * 8 * 144) = xg[8 + i]; } while (0)
#define RT_WLOAD(wd, bt_) do { _Pragma("unroll") for (int q = 0; q < 4; ++q) wd[q] = *(const GAS f32x4*)(wp + ((bt_) * 4 + q) * 256); } while (0)
#define RT_XFRAG(sub_) do { xf[0] = *(const LAS u32x4*)(srb + (sub_) * 32); xf[1] = *(const LAS u32x4*)(srb + (sub_) * 32 + 16); xf[2] = *(const LAS u32x4*)(srr + (sub_) * 16); } while (0)
#define RT_MMA(xd, wd) do { _Pragma("unroll") for (int q = 0; q < 4; ++q) { const unsigned b0 = xd[q >> 1][(q & 1) * 2], b1 = xd[q >> 1][(q & 1) * 2 + 1], r8 = xd[2][q]; \
            const float x0 = bf_lo(b0) + __builtin_amdgcn_cvt_f32_fp8(r8, 0) * XR_INV, x1 = bf_hi(b0) + __builtin_amdgcn_cvt_f32_fp8(r8, 1) * XR_INV, x2 = bf_lo(b1) + __builtin_amdgcn_cvt_f32_fp8(r8, 2) * XR_INV, x3 = bf_hi(b1) + __builtin_amdgcn_cvt_f32_fp8(r8, 3) * XR_INV; \
            acc = __builtin_amdgcn_mfma_f32_32x32x2f32(x0, wd[q][0], acc, 0, 0, 0); acc = __builtin_amdgcn_mfma_f32_32x32x2f32(x1, wd[q][1], acc, 0, 0, 0); \
            acc = __builtin_amdgcn_mfma_f32_32x32x2f32(x2, wd[q][2], acc, 0, 0, 0); acc = __builtin_amdgcn_mfma_f32_32x32x2f32(x3, wd[q][3], acc, 0, 0, 0); } } while (0)
        RT_XLOAD(0); RT_WLOAD(wa, 0);
        __builtin_amdgcn_sched_barrier(0);
#pragma unroll 1
        for (int c = 0; c < 8; ++c) {
            RT_XSTAGE();
            __builtin_amdgcn_sched_barrier(0);
            { const int cn = (c + 1 < 8) ? c + 1 : 7; RT_XLOAD(cn); }
            __builtin_amdgcn_sched_barrier(0);
            RT_WLOAD(wc_, 4 * c + 1); RT_XFRAG(0);
            __builtin_amdgcn_sched_barrier(0);
            RT_MMA(xf, wa);
            __builtin_amdgcn_sched_barrier(0);
            RT_WLOAD(wa, 4 * c + 2); RT_XFRAG(1);
            __builtin_amdgcn_sched_barrier(0);
            RT_MMA(xf, wc_);
            __builtin_amdgcn_sched_barrier(0);
            RT_WLOAD(wc_, 4 * c + 3); RT_XFRAG(2);
            __builtin_amdgcn_sched_barrier(0);
            RT_MMA(xf, wa);
            __builtin_amdgcn_sched_barrier(0);
            { const int bn = (c + 1 < 8) ? 4 * c + 4 : 0; RT_WLOAD(wa, bn); } RT_XFRAG(3);
            __builtin_amdgcn_sched_barrier(0);
            RT_MMA(xf, wc_);
            __builtin_amdgcn_sched_barrier(0);
        }
#undef RT_XLOAD
#undef RT_XSTAGE
#undef RT_WLOAD
#undef RT_XFRAG
#undef RT_MMA
        const float bias = brt[tl];
#pragma unroll
        for (int r = 0; r < 16; ++r) { const int trow = (r & 3) + 8 * (r >> 2) + 4 * hh; LG[trow * 33 + tl] = acc[r] + bias; }
        LDS_WAIT();
        if (lane < 32) { float v[32];
#pragma unroll
            for (int e = 0; e < 32; ++e) v[e] = LG[lane * 33 + e];
            float tv[4]; int ti[4];
#pragma unroll
            for (int p = 0; p < 4; ++p) { float best = -3.0e38f; int bi = 0;
#pragma unroll
                for (int e = 0; e < 32; ++e) { if (v[e] > best) { best = v[e]; bi = e; } }
#pragma unroll
                for (int e = 0; e < 32; ++e) { if (e == bi) v[e] = -3.0e38f; }
                tv[p] = best; ti[p] = bi; }
            const float e1 = __expf(tv[1] - tv[0]), e2 = __expf(tv[2] - tv[0]), e3 = __expf(tv[3] - tv[0]); const float inv = 1.0f / (1.0f + e1 + e2 + e3);
            const float ws[4] = {inv, e1 * inv, e2 * inv, e3 * inv};
#pragma unroll
            for (int p = 0; p < 4; ++p) { const int rank = __hip_atomic_fetch_add(&hist[ti[p]], 1, __ATOMIC_RELAXED, __HIP_MEMORY_SCOPE_WORKGROUP); topi[(size_t)token * 4 + p] = ti[p] | (rank << 8); topw[(size_t)token * 4 + p] = ws[p]; } }
        __syncthreads();
        if (X.tid < 32) __hip_atomic_store(cnt + tile * 32 + X.tid, hist[X.tid], RLX_AGENT);
        __syncthreads();
    }
}

__device__ __forceinline__ void dispatch_phase(const Ctx& X, const int* cnt, const int* topi, int* posmap, int* tile_e  , int* rowtok  , unsigned char* zrow  ) {
    LAS int* s_tot = (LAS int*)X.lds; LAS int* s_seg = s_tot + 32; LAS int* s_mine = s_tot + 96; LAS int* s_pos = s_tot + 128;
    const int tid = X.tid, lane = X.lane;
    LAS int* s_cnt = (LAS int*)(X.lds + 16384);
    __syncthreads();
    for (int i = tid; i < 8192; i += 512) s_cnt[i] = __hip_atomic_load(cnt + i, RLX_AGENT);
    __syncthreads();
    if (tid < 32) { int tot = 0; for (int wg = 0; wg < 256; ++wg) tot += s_cnt[wg * 32 + tid]; s_tot[tid] = tot; }
    __syncthreads();
    if (tid == 0) { int seg = 0; for (int e = 0; e < 32; ++e) { s_seg[e] = seg; seg += (s_tot[e] + 255) & ~255; } s_seg[32] = seg; }
    __syncthreads();
    if (X.bid == 0) { const int nmt = s_seg[32] >> 8;
        for (int mt = tid; mt < nmt; mt += 512) { int e = 0; for (int q = 0; q < 32; ++q) if (s_seg[q] <= mt * 256) e = q; __hip_atomic_store(tile_e + mt, e, RLX_AGENT); }
        if (tid == 0) __hip_atomic_store(tile_e + MAXMT, nmt, RLX_AGENT); }
    if (X.bid == X.G - 1 && tid < 64) *(u32x4*)(zrow + 16 * tid) = (u32x4){0u, 0u, 0u, 0u};
    for (int e = X.bid; e < 32; e += X.G) {
        const int r0 = s_seg[e] + s_tot[e], r1 = s_seg[e + 1];
        for (int i = r0 + tid; i < r1; i += 512) rowtok[i] = T; }
    for (int tile = X.bid; tile < T / 256; tile += X.G) {
        __syncthreads();
        if (tid < 32) { int mine = 0; for (int wg = 0; wg < tile; ++wg) mine += s_cnt[wg * 32 + tid]; s_mine[tid] = mine; }
        __syncthreads();
        for (int idx = tid; idx < 1024; idx += 512) { const int pk = topi[(size_t)tile * 1024 + idx], e = pk & 255, rank = pk >> 8; const int pos = s_seg[e] + s_mine[e] + rank; posmap[(size_t)tile * 1024 + idx] = pos; rowtok[pos] = tile * 256 + (idx >> 2); }
    }
    __syncthreads();
}

struct Args { const float* in[28]; float* out; unsigned char* ws; int lo, hi; };
enum { I_X = 0, I_MEM, I_EV_WIN, I_EV_CA, I_EV_CB, I_EV_CBB, I_EV_WR, I_EV_BR, I_EV_WI, I_EV_BI, I_EV_LAM, I_EV_WOUT, I_OD_WIN, I_OD_BG, I_OD_NG, I_OD_WOUT,
       I_WQ, I_WK, I_WV, I_WO, I_WRT, I_BRT, I_W1, I_B1, I_W2, I_B2, I_LNG, I_LNB };

template <int IDX> __device__ __forceinline__ const float* karg() {
    auto ka = __builtin_amdgcn_kernarg_segment_ptr();
    unsigned long long v; asm volatile("s_load_dwordx2 %0, %1, %2\n\ts_waitcnt lgkmcnt(0)" : "=s"(v) : "s"(ka), "n"(IDX * 8)); return (const float*)v; }
#define KIN(i) karg<i>()

#ifndef PH_MASK
#define PH_MASK 0xffffffffu
#endif
#ifndef REP_MASK
#define REP_MASK 0u
#endif
#define PH_BEGIN(g, kind) if (((PH_MASK >> (kind)) & 1u) && lo <= (g) && (g) < hi) { for (int rep_ = 0; rep_ <= (int)((REP_MASK >> (kind)) & 1u); ++rep_) { Ctx X = X0; X.lane = lane_id_opaque(); X.tid = X.wave * 64 + X.lane; unsigned char* ws = ws0; asm volatile("" : "+s"(ws));
#define PH_END(g) } if ((g) + 1 < hi) xcd_barrier(bar); }

#define XB ((bf16*)(ws + WS_XB))
#define MIX ((bf16*)(ws + WS_MIX))
#define MEMB ((bf16*)(ws + WS_MEMB))
#define KM ((bf16*)(ws + WS_KM))
#define VTm ((bf16*)(ws + WS_VT))
#define XF (out_f32)
#define K2 ((float*)(ws + WS_K2))


template <int LAYER>
__device__ __forceinline__ void layer_body(const Ctx& X0, unsigned char* ws0, float* out_f32, const XcdBarrier& bar, const int lo, const int hi) {
    constexpr int layer = LAYER;
    unsigned char* ws = ws0;
        const int gb = 3 + layer * 16, jl = layer >> 1;
        if ((layer & 1) == 0) {
            bf16* Z = (bf16*)(ws + R_Z); bf16* Y = (bf16*)(ws + WS_Y);
            PH_BEGIN(gb + 0, 2)
                pg8::Gemm g{1024, 1024, 1024};
                pg8::DenseOrder S{(const char*)XB, (const char*)(ws + W_EVIN) + (size_t)jl * EV_IN * 1024 * 2, (size_t)256 * 1024 * 2, (size_t)256 * 1024 * 2, 256, EV_IN / 256, X.G, X.bid};
                pg8::EpiStore E{Z, EV_IN, 0, nullptr, 0, 1.0f, 0};
                pg8::gemm_phase(X.lds, g, S, E, X.wave);
            PH_END(gb + 0)
            PH_BEGIN(gb + 1, 3)
                ya_phase(X, Z, KIN(I_EV_CA) + (size_t)jl * 3 * 512, Y);
                lru_phase(X, Z, (const bf16*)(ws + W_GATE) + (size_t)jl * 8 * 256 * 128, KIN(I_EV_CB) + (size_t)jl * 4 * 1024, KIN(I_EV_CBB) + (size_t)jl * 1024,
                          KIN(I_EV_BR) + (size_t)jl * 1024, KIN(I_EV_BI) + (size_t)jl * 1024, K2 + (size_t)jl * 1024, Y);
            PH_END(gb + 1)
            PH_BEGIN(gb + 4, 6)
                pg8::Gemm g{EV_Y, EV_Y, EV_Y};
                pg8::DenseOrder S{(const char*)Y, (const char*)(ws + W_EVOUT) + (size_t)jl * 1024 * EV_Y * 2, (size_t)256 * EV_Y * 2, (size_t)256 * EV_Y * 2, 256, 4, X.G, X.bid};
                pg8::EpiStore E{MIX, 1024, 0, nullptr, 0, 1.0f, 0};
                pg8::gemm_phase(X.lds, g, S, E, X.wave);
            PH_END(gb + 4)
        } else {
            bf16* ZO = (bf16*)(ws + R_Z); bf16* HB = (bf16*)(ws + R_HB); bf16* Y = (bf16*)(ws + WS_Y); float* GATES = (float*)(ws + WS_GATES);
            PH_BEGIN(gb + 0, 7)
                gates_phase(X, XB, ws + WS_XR8, KIN(I_OD_WIN) + (size_t)jl * 1024 * OD_IN, KIN(I_OD_BG) + (size_t)jl * 8, GATES);
                pg8::Gemm g{1024, 1024, 1024};
                pg8::DenseOrder S{(const char*)XB, (const char*)(ws + W_ODIN) + (size_t)jl * OD_INP * 1024 * 2, (size_t)256 * 1024 * 2, (size_t)256 * 1024 * 2, 256, OD_INP / 256, X.G, X.bid};
                pg8::EpiStore E{ZO, OD_INP, 0, nullptr, 0, 0.08838834764831845f, 2};
                pg8::gemm_phase(X.lds, g, S, E, X.wave);
            PH_END(gb + 0)
            PH_BEGIN(gb + 1, 8)
                mlstm_phase(X, ZO, GATES, HB);
            PH_END(gb + 1)
            PH_BEGIN(gb + 2, 9)
                hnorm_phase(X, HB, ZO, KIN(I_OD_NG) + (size_t)jl * 1024, Y);
            PH_END(gb + 2)
            PH_BEGIN(gb + 4, 10)
                pg8::Gemm g{1024, 1024, 1024};
                pg8::DenseOrder S{(const char*)Y, (const char*)(ws + W_ODOUT) + (size_t)jl * 1024 * 1024 * 2, (size_t)256 * 1024 * 2, (size_t)256 * 1024 * 2, 256, 4, X.G, X.bid};
                pg8::EpiStore E{MIX, 1024, 0, nullptr, 0, 1.0f, 0};
                pg8::gemm_phase(X.lds, g, S, E, X.wave);
            PH_END(gb + 4)
        }
        PH_BEGIN(gb + 5, 11)
            ln_phase<false, 4>(X, layer == 0 ? KIN(I_X) : nullptr, MIX, nullptr, nullptr, KIN(I_LNG) + (size_t)layer * 3 * D, KIN(I_LNB) + (size_t)layer * 3 * D, nullptr, XB, ws + WS_XR8, ws + R_XA8);
        PH_END(gb + 5)
        {
            bf16* Q = (bf16*)(ws + R_Q); bf16* P = (bf16*)(ws + R_P); bf16* O = (bf16*)(ws + R_O);
            PH_BEGIN(gb + 6, 12)
                pg8::Gemm g{512, 512, 512};
                pg8::BatchOrder S{(const char*)(ws + R_XA8), (const char*)(ws + WS_M1) + (size_t)layer * 16 * 1024 * 1024, (size_t)256 * 1024, (size_t)0, (size_t)1024 * 1024, (size_t)256 * 1024, 4, 256, 4, X.G, X.bid};
                pg8::EpiSoftmax E{(unsigned char*)P, 0.0625f / M1_SCALE};
                pg8::gemm_phase<pg8::EpiSoftmax, pg8::BatchOrder, true>(X.lds, g, S, E, X.wave);
            PH_END(gb + 6)
            PH_BEGIN(gb + 9, 15)
                pg8::Gemm g{512, 512, 512};
                pg8::BatchOrder S{(const char*)P, (const char*)(ws + WS_M2) + (size_t)layer * 16 * 1024 * 1024, (size_t)256 * 1024, (size_t)0, (size_t)1024 * 1024, (size_t)256 * 1024, 4, 256, 4, X.G, X.bid};
                pg8::EpiStore E{MIX, 1024, 0, nullptr, 0, 1.0f, 0, 1.0f / (256.0f * M2_SCALE)};
                pg8::gemm_phase<pg8::EpiStore, pg8::BatchOrder, true>(X.lds, g, S, E, X.wave);
            PH_END(gb + 9)
        }
        PH_BEGIN(gb + 10, 16)
            ln_phase<false, 4>(X, nullptr, MIX, nullptr, nullptr, KIN(I_LNG) + (size_t)layer * 3 * D + D, KIN(I_LNB) + (size_t)layer * 3 * D + D, nullptr, XB, ws + WS_XR8, ws + R_XG);
        PH_END(gb + 10)
        {
            int* topi = (int*)(ws + WS_TOPI); float* topw = (float*)(ws + WS_TOPW); int* posmap = (int*)(ws + WS_POSMAP);
            int* cnt = (int*)(ws + WS_CNT) + (size_t)layer * 8192; int* tile_e = (int*)(ws + WS_TILEE) + (size_t)layer * 2048;
            unsigned char* XG = ws + R_XG; unsigned char* HID = ws + R_HID; bf16* EO = (bf16*)(ws + R_EO);
            PH_BEGIN(gb + 11, 17)
                router_phase(X, XB, ws + WS_XR8, (const float*)(ws + WS_WRT) + (size_t)layer * 32 * 1024, KIN(I_BRT) + (size_t)layer * 32, topi, topw, cnt);
            PH_END(gb + 11)
            PH_BEGIN(gb + 12, 18)
                dispatch_phase(X, cnt, topi, posmap, tile_e, (int*)(ws + WS_ROWTOK), XG + (size_t)T * D);
            PH_END(gb + 12)
            PH_BEGIN(gb + 13, 19)
                const int nmt = __builtin_amdgcn_readfirstlane(__hip_atomic_load(tile_e + MAXMT, RLX_AGENT));
                pg8::Gemm g{512, 512, 512, (const int*)(ws + WS_ROWTOK)};
                LAS int* te = (LAS int*)(X.lds + XCH_OFF); for (int i = X.tid; i < nmt; i += 512) te[i] = __hip_atomic_load(tile_e + i, RLX_AGENT); __syncthreads();
                pg8::MoeOrder S{(const char*)XG, (const char*)(ws + W_1) + (size_t)layer * 32 * 2048 * 1024, (size_t)0, (size_t)2048 * 1024, (size_t)256 * 1024, te, nmt, 8, X.G, X.bid};
                pg8::EpiSwiglu E{HID, KIN(I_B1) + (size_t)layer * 32 * 2048, 1.0f / W1_SCALE};
                pg8::gemm_phase<pg8::EpiSwiglu, pg8::MoeOrder, true, true>(X.lds, g, S, E, X.wave);
            PH_END(gb + 13)
            PH_BEGIN(gb + 14, 20)
                const int nmt = __builtin_amdgcn_readfirstlane(__hip_atomic_load(tile_e + MAXMT, RLX_AGENT));
                pg8::Gemm g{512, 512, 512};
                LAS int* te = (LAS int*)(X.lds + XCH_OFF); for (int i = X.tid; i < nmt; i += 512) te[i] = __hip_atomic_load(tile_e + i, RLX_AGENT); __syncthreads();
                pg8::MoeOrder S{(const char*)HID, (const char*)(ws + W_2) + (size_t)layer * 32 * 1024 * 1024, (size_t)256 * 1024, (size_t)1024 * 1024, (size_t)256 * 1024, te, nmt, 4, X.G, X.bid};
                pg8::EpiStore8T<true> E{(unsigned char*)EO, 1024, EO_SCALE, KIN(I_B2) + (size_t)layer * 32 * 1024, 1024, 1.0f / W2_SCALE};
                pg8::gemm_phase<pg8::EpiStore8T<true>, pg8::MoeOrder, true>(X.lds, g, S, E, X.wave);
            PH_END(gb + 14)
            PH_BEGIN(gb + 15, 21)
                ln_phase<true, 2>(X, nullptr, EO, posmap, topw, KIN(I_LNG) + (size_t)layer * 3 * D + 2 * D, KIN(I_LNB) + (size_t)layer * 3 * D + 2 * D, layer == DEPTH - 1 ? XF : nullptr, XB, ws + WS_XR8);
            PH_END(gb + 15)
        }
    }

__global__ void __launch_bounds__(512, 2) mk_fwd(Args args) {
    extern __shared__ __attribute__((aligned(16))) unsigned char lds_raw[];
    Ctx X0; X0.lds = (LAS unsigned char*)lds_raw; X0.tid = threadIdx.x; X0.lane = X0.tid & 63; X0.wave = __builtin_amdgcn_readfirstlane(X0.tid >> 6);     X0.bid = blockIdx.x; X0.G = gridDim.x;
    unsigned char* ws0 = args.ws;
    unsigned char* ws = ws0;
    volatile LAS unsigned* MISC = (volatile LAS unsigned*)(X0.lds + MISC_OFF);
    if (X0.tid < 64) MISC[X0.tid] = 0u;
    __syncthreads();
    XcdBarrier bar; bar.bar = (unsigned*)(ws + WS_CTL) + CW_BAR; bar.x = 0; bar.st = MISC; bar.wave = X0.wave;
    if (args.hi - args.lo > 1) bar = xcd_barrier_post((unsigned*)(ws + WS_CTL) + CW_BAR, MISC, X0.wave);
    const int lo = args.lo, hi = args.hi;
    PH_BEGIN(0, 0)
        conv_group(X, KIN(I_EV_WIN), 2, 1024, EV_IN, EV_IN, (size_t)1024 * EV_IN, (bf16*)(ws + W_EVIN), (size_t)EV_IN * 1024, 0);
        conv_group(X, KIN(I_EV_WOUT), 2, EV_Y, 1024, 1024, (size_t)EV_Y * 1024, (bf16*)(ws + W_EVOUT), (size_t)1024 * EV_Y, 0);
        conv_group(X, KIN(I_EV_WR), 16, 128, 128, 128, (size_t)128 * 128, (bf16*)(ws + W_GATE), (size_t)256 * 128, 0);
        conv_group(X, KIN(I_EV_WI), 16, 128, 128, 128, (size_t)128 * 128, (bf16*)(ws + W_GATE) + 128 * 128, (size_t)256 * 128, 0);
        conv_group(X, KIN(I_OD_WIN), 2, 1024, OD_INP, OD_IN, (size_t)1024 * OD_IN, (bf16*)(ws + W_ODIN), (size_t)OD_INP * 1024, 0);
        conv_group(X, KIN(I_OD_WOUT), 2, 1024, 1024, 1024, (size_t)1024 * 1024, (bf16*)(ws + W_ODOUT), (size_t)1024 * 1024, 0);
        cvt_flat8(X, KIN(I_WQ), ws + W_Q, (size_t)4 * 1024 * 1024, WQ_SCALE);
        conv_group(X, KIN(I_WK), 4, 1024, 1024, 1024, (size_t)1024 * 1024, (bf16*)(ws + W_K), (size_t)1024 * 1024, 0, WQ_SCALE);
        conv_group(X, KIN(I_WV), 4, 1024, 1024, 1024, (size_t)1024 * 1024, (bf16*)(ws + W_V), (size_t)1024 * 1024, 0, WQ_SCALE);
        conv_group(X, KIN(I_WO), 4, 1024, 1024, 1024, (size_t)1024 * 1024, (bf16*)(ws + W_O), (size_t)1024 * 1024, 0, WO_SCALE);
        conv_group(X, KIN(I_W1), 128, 1024, 2048, 2048, (size_t)1024 * 2048, (bf16*)(ws + W_1), (size_t)2048 * 1024, 1, W1_SCALE);
        conv_group(X, KIN(I_W2), 128, 1024, 1024, 1024, (size_t)1024 * 1024, (bf16*)(ws + W_2), (size_t)1024 * 1024, 0, W2_SCALE);
        cvt_flat(X, KIN(I_X), XB, (size_t)T * D);
        cvt_flat8(X, KIN(I_MEM), (unsigned char*)MEMB, (size_t)NBATCH * NMEM * D);
        for (int i = X.bid * 512 + X.tid; i < 4 * 32 * 1024; i += X.G * 512) { const int l = i >> 15, r = i & 32767, bt = r >> 10, q = (r >> 8) & 3, ln = (r >> 2) & 63; const int k = 128 * (bt >> 2) + 64 * (ln >> 5) + 16 * (bt & 3) + 4 * q + (r & 3), e = ln & 31;
            ((float*)(ws + WS_WRT))[i] = KIN(I_WRT)[(size_t)l * 32768 + k * 32 + e]; }
        for (int i = X.bid * 512 + X.tid; i < 2048; i += X.G * 512) { const float lam = KIN(I_EV_LAM)[i]; const float sp = fmaxf(-lam, 0.f) + log1pf(__expf(-fabsf(lam)));
            K2[i] = -8.0f * sp * 1.4426950408889634f; }
        __syncthreads();
    PH_END(0)

    PH_BEGIN(1, 1)
        { pg8::Gemm g{512, 512, 512};
          pg8::StackOrder S{(const char*)MEMB, (const char*)(ws + W_K), (size_t)256 * 1024, (size_t)256 * 1024, 0, (size_t)1024 * 1024, 16, 4, 4, X.G, X.bid};
          pg8::EpiStore8 E{(unsigned char*)KM, 1024, 1.0f / WQ_SCALE, nullptr, 0, 1.0f, (size_t)4096 * 1024};
          pg8::gemm_phase<pg8::EpiStore8, pg8::StackOrder, true>(X.lds, g, S, E, X.wave); }
        { pg8::Gemm g{512, 512, 512};
          pg8::StackOrder S{(const char*)MEMB, (const char*)(ws + W_V), (size_t)256 * 1024, (size_t)256 * 1024, 0, (size_t)1024 * 1024, 16, 4, 4, X.G, X.bid};
          pg8::EpiStore8 E{(unsigned char*)VTm, 1024, 1.0f / WQ_SCALE, nullptr, 0, 1.0f, (size_t)4096 * 1024};
          pg8::gemm_phase<pg8::EpiStore8, pg8::StackOrder, true>(X.lds, g, S, E, X.wave); }
    PH_END(1)

    PH_BEGIN(2, 22)
        { pg8::Gemm g{512, 512, 128};
          pg8::FoldOrder S{(const char*)KM, (const char*)(ws + W_Q), false, X.G, X.bid};
          pg8::EpiStore8 E{ws + WS_M1, 1024, M1_SCALE / WQ_SCALE, nullptr, 0, 1.0f, (size_t)256 * 1024};
          pg8::gemm_phase<pg8::EpiStore8, pg8::FoldOrder, true>(X.lds, g, S, E, X.wave); }
        { pg8::Gemm g{512, 512, 128};
          pg8::FoldOrder S{(const char*)(ws + W_O), (const char*)VTm, true, X.G, X.bid};
          pg8::EpiStore8 E{ws + WS_M2, 1024, M2_SCALE / WO_SCALE, nullptr, 0, 1.0f, (size_t)1024 * 1024};
          pg8::gemm_phase<pg8::EpiStore8, pg8::FoldOrder, true>(X.lds, g, S, E, X.wave); }
    PH_END(2)

    layer_body<0>(X0, ws0, args.out, bar, lo, hi); layer_body<1>(X0, ws0, args.out, bar, lo, hi); layer_body<2>(X0, ws0, args.out, bar, lo, hi); layer_body<3>(X0, ws0, args.out, bar, lo, hi);
#undef PH_BEGIN
#undef PH_END
}

extern "C" void kernel_launch(void* const* d_in, const int* in_sizes, int n_in, void* d_out, int out_size, void* d_ws, size_t ws_size, hipStream_t stream) {
    static int grid = 0;
    if (grid == 0) {
        if (n_in != 28 || in_sizes[0] != T * D || out_size != T * D || ws_size < WS_END) { fprintf(stderr, "kernel_launch: unexpected shapes (n_in %d, in0 %d, out %d, ws %zu, need %zu); nothing launched\n", n_in, n_in > 0 ? in_sizes[0] : -1, out_size, ws_size, (size_t)WS_END); grid = -1; return; }
        int dev = 0, cus = 0, per_cu = 0;
        if (hipGetDevice(&dev) != hipSuccess || hipDeviceGetAttribute(&cus, hipDeviceAttributeMultiprocessorCount, dev) != hipSuccess) { grid = -1; return; }
        if (hipFuncSetAttribute((const void*)mk_fwd, hipFuncAttributeMaxDynamicSharedMemorySize, LDS_BYTES) != hipSuccess) { fprintf(stderr, "kernel_launch: hipFuncSetAttribute failed\n"); grid = -1; return; }
        if (hipOccupancyMaxActiveBlocksPerMultiprocessor(&per_cu, (const void*)mk_fwd, 512, LDS_BYTES) != hipSuccess || per_cu < 1) { fprintf(stderr, "kernel_launch: occupancy query reports %d\n", per_cu); }
        (void)hipGetLastError();
        grid = cus;
    }
    if (grid < 0) return;
    if (hipMemsetAsync((char*)d_ws + WS_CTL, 0, CTL_ZERO_BYTES, stream) != hipSuccess) return;
    Args a{};
    for (int i = 0; i < 28; ++i) a.in[i] = (const float*)d_in[i];
    a.out = (float*)d_out; a.ws = (unsigned char*)d_ws;
#if MK_N_LAUNCHES == 1
    a.lo = 0; a.hi = 3 + DEPTH * 16;
    hipLaunchKernelGGL(mk_fwd, dim3(grid), dim3(512), LDS_BYTES, stream, a);
#else
    for (int g = 0; g < 3 + DEPTH * 16; ++g) {
        if (g >= 3) { const int layer = (g - 3) / 16, k = (g - 3) % 16; if (k == 7 || k == 8) continue; if ((layer & 1) && k == 3) continue; if (!(layer & 1) && (k == 2 || k == 3)) continue; }
        a.lo = g; a.hi = g + 1;
        hipLaunchKernelGGL(mk_fwd, dim3(grid), dim3(512), LDS_BYTES, stream, a);
    }
#endif
}
```
